# Optimizing an MI355X kernel written in HIP

```python
import math
import jax, jax.numpy as jnp
from jax import lax
import numpy as np

D_MODEL = 1024
BATCH = 8
SEQ = 8192
DEPTH = 1

HEAD_DIM = 64
D_MIX = D_MODEL
N_HEADS_DIL = (D_MIX // 2) // HEAD_DIM
N_HEADS_SB = (D_MIX // 2) // HEAD_DIM
D_DIL = N_HEADS_DIL * HEAD_DIM
D_SB = N_HEADS_SB * HEAD_DIM
DIL_PATTERNS = ((128, 1), (512, 4), (2048, 16))
BLK = 128
REL_BUCKETS = 32
REL_MAX_DISTANCE = 2048
N_EXPERTS = 32
TOP_K = 4
D_EXPERT = D_MODEL
SWIGLU_ALPHA = 1.702
SWIGLU_LIMIT = 7.0
MOE_BLK = 256
RMS_EPS = 1e-6
NEG_INF = -1e30

kernel_name = "hybrid_dilated_stickbreaking_moe_layer"


def rmsnorm(x, g):
    x32 = x.astype(jnp.float32)
    y = x32 * lax.rsqrt(jnp.mean(x32 * x32, axis=-1, keepdims=True) + RMS_EPS)
    return (y * g.astype(jnp.float32)).astype(x.dtype)


def t5_bucket(dist):
    max_exact = REL_BUCKETS // 2
    d_f = jnp.maximum(dist, 1).astype(jnp.float32)
    large = max_exact + (jnp.log(d_f / max_exact)
                         / math.log(REL_MAX_DISTANCE / max_exact)
                         * (REL_BUCKETS - max_exact)).astype(jnp.int32)
    large = jnp.minimum(large, REL_BUCKETS - 1)
    return jnp.where(dist < max_exact, dist, large)


def dilated_window_attention(q, k, v, rel_table, window, dilation):
    B, S, H, Dh = q.shape
    d = dilation
    band = window // d
    L = S // d
    nblk = -(-L // BLK)
    Lp = nblk * BLK

    def to_strided(a):
        a = a.astype(jnp.float32).reshape(B, L, d, H, Dh).transpose(0, 2, 1, 3, 4)
        a = jnp.pad(a, ((0, 0), (0, 0), (0, Lp - L), (0, 0), (0, 0)))
        return a.reshape(B, d, nblk, BLK, H, Dh)

    def with_prev(a):
        prev = jnp.pad(a[:, :, :-1], ((0, 0), (0, 0), (1, 0), (0, 0), (0, 0), (0, 0)))
        return jnp.concatenate([prev, a], axis=3)

    qs = to_strided(q)
    kc = with_prev(to_strided(k))
    vc = with_prev(to_strided(v))

    qi = jnp.arange(BLK, dtype=jnp.int32)[:, None]
    kj = jnp.arange(2 * BLK, dtype=jnp.int32)[None, :]
    rel = qi + BLK - kj
    band_ok = (rel >= 0) & (rel <= band)
    key_pos = jnp.arange(nblk, dtype=jnp.int32)[:, None, None] * BLK - BLK + kj[None]
    valid = band_ok[None] & (key_pos >= 0)
    bias = rel_table.astype(jnp.float32)[t5_bucket(jnp.maximum(rel, 0) * d)]
    bias = bias.transpose(2, 0, 1)

    scale = 1.0 / math.sqrt(Dh)
    logits = jnp.einsum('brnqhd,brnkhd->brnhqk', qs, kc) * scale + bias
    vmask = valid[None, None, :, None]
    logits = jnp.where(vmask, logits, NEG_INF)
    m = jnp.max(logits, axis=-1, keepdims=True)
    p = jnp.where(vmask, jnp.exp(logits - m), 0.0)
    s = jnp.sum(p, axis=-1, keepdims=True)
    o = jnp.einsum('brnhqk,brnkhd->brnqhd', p / s, vc)
    lse = (m + jnp.log(s))[..., 0]

    o = o.reshape(B, d, Lp, H, Dh)[:, :, :L].transpose(0, 2, 1, 3, 4).reshape(B, S, H, Dh)
    lse = lse.transpose(0, 1, 2, 4, 3).reshape(B, d, Lp, H)[:, :, :L]
    lse = lse.transpose(0, 2, 1, 3).reshape(B, S, H)
    return o, lse


def dilated_mixture(q, k, v, rel_table):
    outs, lses = [], []
    for window, dilation in DIL_PATTERNS:
        o, l = dilated_window_attention(q, k, v, rel_table, window, dilation)
        outs.append(o)
        lses.append(l)
    w = jax.nn.softmax(jnp.stack(lses, axis=0), axis=0)
    return jnp.sum(w[..., None] * jnp.stack(outs, axis=0), axis=0)


def stick_breaking_attention(q, k, v):
    B, S, H, Dh = q.shape
    nq = S // BLK
    scale = 1.0 / math.sqrt(Dh)
    k32 = k.astype(jnp.float32)
    v32 = v.astype(jnp.float32)
    key_idx = jnp.arange(S, dtype=jnp.int32)

    def block(args):
        qb, t0 = args
        z = jnp.einsum('bqhd,bkhd->bhqk', qb.astype(jnp.float32), k32) * scale
        tq = t0 + jnp.arange(BLK, dtype=jnp.int32)
        mask = key_idx[None, :] < tq[:, None]
        log_beta = jax.nn.log_sigmoid(z)
        log_1m = jnp.where(mask, jax.nn.log_sigmoid(-z), 0.0)
        between = lax.cumsum(log_1m, axis=3, reverse=True) - log_1m
        a = jnp.where(mask, jnp.exp(log_beta + between), 0.0)
        return jnp.einsum('bhqk,bkhd->bqhd', a, v32)

    qb = q.reshape(B, nq, BLK, H, Dh).transpose(1, 0, 2, 3, 4)
    starts = jnp.arange(nq, dtype=jnp.int32) * BLK
    o = lax.map(block, (qb, starts))
    return o.transpose(1, 0, 2, 3, 4).reshape(B, S, H, Dh)


def moe(h, w_router, b_router, w_gate, b_gate, w_up, b_up, w_down, b_down):
    B, S, D = h.shape
    N = B * S
    t = h.reshape(N, D)
    logits = jnp.matmul(t, w_router).astype(jnp.float32) + b_router.astype(jnp.float32)
    top_vals, top_idx = lax.top_k(logits, TOP_K)
    gates = jax.nn.softmax(top_vals, axis=-1)

    n_assign = N * TOP_K
    flat_e = top_idx.reshape(-1).astype(jnp.int32)
    flat_tok = jnp.repeat(jnp.arange(N, dtype=jnp.int32), TOP_K)
    flat_g = gates.reshape(-1)
    order = jnp.argsort(flat_e)
    e_sorted = flat_e[order]
    counts = jnp.bincount(flat_e, length=N_EXPERTS).astype(jnp.int32)
    padded = (counts + MOE_BLK - 1) // MOE_BLK * MOE_BLK
    start = jnp.cumsum(counts) - counts
    pend = jnp.cumsum(padded)
    pstart = pend - padded
    rank = jnp.arange(n_assign, dtype=jnp.int32) - start[e_sorted]
    dest = pstart[e_sorted] + rank

    n_slots = -(-(n_assign + N_EXPERTS * (MOE_BLK - 1)) // MOE_BLK) * MOE_BLK
    n_blocks = n_slots // MOE_BLK
    slot_tok = jnp.full((n_slots,), N, jnp.int32).at[dest].set(flat_tok[order])
    slot_gate = jnp.zeros((n_slots,), jnp.float32).at[dest].set(flat_g[order])
    block_start = jnp.arange(n_blocks, dtype=jnp.int32) * MOE_BLK
    block_expert = jnp.minimum(jnp.searchsorted(pend, block_start, side='right'),
                               N_EXPERTS - 1).astype(jnp.int32)
    t_pad = jnp.concatenate([t, jnp.zeros((1, D), t.dtype)], axis=0)

    def expert_block(args):
        tok, g, e = args
        xb = t_pad[tok]
        x_glu = (jnp.matmul(xb, w_gate[e]) + b_gate[e]).astype(jnp.float32)
        x_lin = (jnp.matmul(xb, w_up[e]) + b_up[e]).astype(jnp.float32)
        x_glu = jnp.minimum(x_glu, SWIGLU_LIMIT)
        x_lin = jnp.clip(x_lin, -SWIGLU_LIMIT, SWIGLU_LIMIT)
        act = (x_glu * jax.nn.sigmoid(SWIGLU_ALPHA * x_glu) * (x_lin + 1.0)).astype(xb.dtype)
        y = (jnp.matmul(act, w_down[e]) + b_down[e]).astype(jnp.float32)
        return (y * g[:, None]).astype(t.dtype)

    ys = lax.map(expert_block, (slot_tok.reshape(n_blocks, MOE_BLK),
                                slot_gate.reshape(n_blocks, MOE_BLK), block_expert))
    out = jax.ops.segment_sum(ys.reshape(n_slots, D), slot_tok, num_segments=N + 1)[:N]
    return out.reshape(B, S, D)


def setup_inputs(seed: int = 0) -> dict:
    key = jax.random.key(seed)
    ks = jax.random.split(key, 20)
    f32 = jnp.float32
    nrm = lambda k, shape, s: jax.random.normal(k, shape, f32) * s
    return {
        "x": nrm(ks[0], (BATCH, SEQ, D_MODEL), 1.0),
        "g_attn": 1.0 + nrm(ks[1], (D_MODEL,), 0.02),
        "w_qkv": nrm(ks[2], (D_MODEL, 3 * D_MIX), D_MODEL ** -0.5),
        "rel_bias": nrm(ks[3], (REL_BUCKETS, N_HEADS_DIL), 0.1),
        "g_out_dil": 1.0 + nrm(ks[4], (D_DIL,), 0.02),
        "g_out_sb": 1.0 + nrm(ks[5], (D_SB,), 0.02),
        "w_o": nrm(ks[6], (D_MIX, D_MODEL), D_MIX ** -0.5),
        "g_moe": 1.0 + nrm(ks[7], (D_MODEL,), 0.02),
        "w_router": nrm(ks[8], (D_MODEL, N_EXPERTS), D_MODEL ** -0.5),
        "b_router": nrm(ks[9], (N_EXPERTS,), 0.01),
        "w_gate": nrm(ks[10], (N_EXPERTS, D_MODEL, D_EXPERT), D_MODEL ** -0.5),
        "b_gate": nrm(ks[11], (N_EXPERTS, D_EXPERT), 0.02),
        "w_up": nrm(ks[12], (N_EXPERTS, D_MODEL, D_EXPERT), D_MODEL ** -0.5),
        "b_up": nrm(ks[13], (N_EXPERTS, D_EXPERT), 0.02),
        "w_down": nrm(ks[14], (N_EXPERTS, D_EXPERT, D_MODEL), D_EXPERT ** -0.5),
        "b_down": nrm(ks[15], (N_EXPERTS, D_MODEL), 0.02),
        "g_final": 1.0 + nrm(ks[16], (D_MODEL,), 0.02),
    }


def reference(x, g_attn, w_qkv, rel_bias, g_out_dil, g_out_sb, w_o, g_moe,
              w_router, b_router, w_gate, b_gate, w_up, b_up, w_down, b_down, g_final):
    B, S, _ = x.shape
    for _layer in range(DEPTH):
        h = rmsnorm(x, g_attn)
        qkv = jnp.matmul(h, w_qkv)
        qa, ka, va, qb, kb, vb = jnp.split(
            qkv, [D_DIL, 2 * D_DIL, 3 * D_DIL, 3 * D_DIL + D_SB, 3 * D_DIL + 2 * D_SB], axis=-1)
        heads_a = lambda a: a.reshape(B, S, N_HEADS_DIL, HEAD_DIM)
        heads_b = lambda a: a.reshape(B, S, N_HEADS_SB, HEAD_DIM)
        oa = dilated_mixture(heads_a(qa), heads_a(ka), heads_a(va), rel_bias)
        oa = rmsnorm(oa.reshape(B, S, D_DIL).astype(x.dtype), g_out_dil)
        ob = stick_breaking_attention(heads_b(qb), heads_b(kb), heads_b(vb))
        ob = rmsnorm(ob.reshape(B, S, D_SB).astype(x.dtype), g_out_sb)
        mix = jnp.matmul(jnp.concatenate([oa, ob], axis=-1), w_o)
        x = x + mix
        x = x + moe(rmsnorm(x, g_moe), w_router, b_router, w_gate, b_gate,
                    w_up, b_up, w_down, b_down)
    return rmsnorm(x, g_final)
```

```cpp
#include <hip/hip_runtime.h>
#include <cstdio>
#include <cstdint>

#define GAS __attribute__((address_space(1)))
#define LAS __attribute__((address_space(3)))

constexpr int BATCH = 8, SEQ = 8192, DM = 1024, NTOK = BATCH * SEQ;
constexpr int NQKV = 3072, NEXP = 32, TOPK = 4, DEXP = 1024;
constexpr int MAXRB = NTOK * TOPK / 256 + NEXP;
constexpr int NSLOT = MAXRB * 256;
constexpr float RMS_EPS = 1e-6f;
constexpr float LOG2E = 1.4426950408889634f;
constexpr float QSCALE = 0.125f * LOG2E;

namespace pg8 {
#define PG8_LAS __attribute__((address_space(3)))
typedef unsigned short bf16_t;
typedef short bf16x8 __attribute__((ext_vector_type(8)));
typedef float f32x4 __attribute__((ext_vector_type(4)));
typedef unsigned u32x4 __attribute__((ext_vector_type(4)));
typedef unsigned u32x2 __attribute__((ext_vector_type(2)));
constexpr int BM = 256, BK = 64, HALF = 128, HTB = HALF * BK * 2, STAGE_BYTES = 8 * HTB, NXCD = 8, WGM = 8;

__host__ __device__ __forceinline__ int lds_byte(int r, int c) { const int st = (r >> 4) * 2 + (c >> 5), rr = r & 15, cc = c & 31, ob = rr * 64 + cc * 2; return st * 1024 + (ob ^ (((ob >> 9) & 1) << 5)); }
__host__ __device__ __forceinline__ void stage_rc(int b, int& R, int& C) { const int st = b / 1024, sb = b % 1024, swz = sb ^ (((sb >> 9) & 1) << 5); R = (st >> 1) * 16 + swz / 64; C = (st & 1) * 32 + (swz % 64) / 2; }
__host__ __device__ __forceinline__ int perm32(int rho) { const int n = rho >> 4, i = rho & 15; return 8 * (i >> 2) + 4 * n + (i & 3); }

struct Unit { int pm, pn, e, r0, nv; };

__device__ __forceinline__ unsigned cvt_pk_bf16(float lo, float hi) { unsigned r; asm volatile("v_cvt_pk_bf16_f32 %0, %1, %2" : "=v"(r) : "v"(lo), "v"(hi)); return r; }

struct DenseOrder {
    int nM, nN, nwg, G, c, K; const char* Bt;
    __device__ void init(int M, int N, int K_, int G_, int c_, const void* Bt_) { nM = M / BM; nN = N / BM; nwg = nM * nN; G = G_; c = c_; K = K_; Bt = (const char*)Bt_; }
    __device__ __forceinline__ bool next(int i, Unit& u) const {
        const long L = (long)i * G + c; if (L >= nwg) return false;
        int wgid = (int)L; { const int q = nwg / NXCD, r = nwg % NXCD, xcd = wgid % NXCD, off = wgid / NXCD; wgid = (xcd < r ? xcd * (q + 1) : r * (q + 1) + (xcd - r) * q) + off; }
        const int nig = WGM * nN, gid = wgid / nig, fm = gid * WGM, gsz = (nM - fm) < WGM ? (nM - fm) : WGM;
        u.pm = fm + ((wgid % nig) % gsz); u.pn = (wgid % nig) / gsz; u.e = 0; u.r0 = 0; u.nv = 256; return true;
    }
    static constexpr bool GATHER = false;
    __device__ __forceinline__ const char* bbase(const Unit& u) const { return Bt + (size_t)u.pn * BM * K * 2; }
    __device__ __forceinline__ size_t abase(const Unit& u) const { return (size_t)u.pm * BM * K * 2; }
    __device__ __forceinline__ void aoffs(const Unit&, int, unsigned (&)[2][2]) const {}
};
template <bool GATHER_> struct MoeOrder {
    static constexpr bool GATHER = GATHER_;
    int G, c, NT, nRB, K; const char* W; size_t wstride; const PG8_LAS int* rbtab; const PG8_LAS int* cntl; const int* tok_list;
    __device__ __forceinline__ bool next(int i, Unit& u) const {
        const int L = i * G + c, per = 8 * NT, grp = L / per, rem = L % per, j = rem >> 3, rb = grp * 8 + (rem & 7);
        if (rb >= nRB) return false;
        const int pk = rbtab[rb]; u.e = pk >> 16; u.pm = rb; u.pn = j; u.r0 = (pk & 0xffff) * 256; const int left = cntl[u.e] - u.r0; u.nv = left < 256 ? left : 256; return true;
    }
    __device__ __forceinline__ const char* bbase(const Unit& u) const { return W + (size_t)u.e * wstride + (size_t)u.pn * BM * K * 2; }
    __device__ __forceinline__ size_t abase(const Unit& u) const { return GATHER ? (size_t)0 : (size_t)u.pm * BM * K * 2; }
    __device__ __forceinline__ void aoffs(const Unit& u, int tid, unsigned (&o)[2][2]) const {
        if (GATHER) {
            asm volatile("" : "+v"(tid));
#pragma unroll
            for (int i = 0; i < 2; ++i) { int R, C; stage_rc(tid * 16 + i * 8192, R, C);
#pragma unroll
                for (int h = 0; h < 2; ++h) { const int rl = h * HALF + R; int tok = 0; if (rl < u.nv) tok = tok_list[(size_t)u.e * NTOK + u.r0 + rl]; o[h][i] = (unsigned)(tok * K + C) * 2u; } }
        }
    }
};

struct EpiQKV {
    static constexpr bool PERM = true;
    bf16_t* O; int ldc;
    __device__ __forceinline__ void operator()(const f32x4 (&acc)[2][2][4][2], const Unit& u, int wr, int wc, int fr, int fq) const {
        const int row0 = u.pm * BM + wr * 64 + fr, col0 = u.pn * BM + wc * 32 + 8 * fq;
#pragma unroll
        for (int ai = 0; ai < 2; ++ai)
#pragma unroll
            for (int m = 0; m < 4; ++m) { bf16_t* rowp = O + (size_t)(row0 + ai * HALF + m * 16) * ldc + col0;
#pragma unroll
                for (int bj = 0; bj < 2; ++bj) { const f32x4 v0 = acc[ai][bj][m][0], v1 = acc[ai][bj][m][1];
                    u32x4 w; w.x = cvt_pk_bf16(v0[0], v0[1]); w.y = cvt_pk_bf16(v0[2], v0[3]); w.z = cvt_pk_bf16(v1[0], v1[1]); w.w = cvt_pk_bf16(v1[2], v1[3]);
                    *(u32x4*)(rowp + bj * HALF) = w; } }
    }
};
struct EpiWo {
    static constexpr bool PERM = false;
    const float* X; float* X1; bf16_t* X1b;
    __device__ __forceinline__ void operator()(const f32x4 (&acc)[2][2][4][2], const Unit& u, int wr, int wc, int fr, int fq) const {
        const int row0 = u.pm * BM + wr * 64 + fr, col0 = u.pn * BM + wc * 32 + 4 * fq;
#pragma unroll
        for (int ai = 0; ai < 2; ++ai)
#pragma unroll
            for (int m = 0; m < 4; ++m) { const size_t off = (size_t)(row0 + ai * HALF + m * 16) * DM + col0;
#pragma unroll
                for (int bj = 0; bj < 2; ++bj)
#pragma unroll
                    for (int n = 0; n < 2; ++n) { const size_t o2 = off + bj * HALF + n * 16; const f32x4 v = *(const f32x4*)(X + o2) + acc[ai][bj][m][n];
                        *(f32x4*)(X1 + o2) = v; u32x2 w; w.x = cvt_pk_bf16(v[0], v[1]); w.y = cvt_pk_bf16(v[2], v[3]); *(u32x2*)(X1b + o2) = w; } }
    }
};
struct EpiGU {
    static constexpr bool PERM = true;
    bf16_t* ACT; const float* bg; const float* bu; const float* rs_list;
    __device__ __forceinline__ void operator()(const f32x4 (&acc)[2][2][4][2], const Unit& u, int wr, int wc, int fr, int fq) const {
        const int rl0 = wr * 64 + fr, colt = u.pn * HALF + wc * 32 + 8 * fq;
        f32x4 bgv[2], buv[2];
#pragma unroll
        for (int n = 0; n < 2; ++n) { bgv[n] = *(const f32x4*)(bg + (size_t)u.e * DEXP + colt + 4 * n); buv[n] = *(const f32x4*)(bu + (size_t)u.e * DEXP + colt + 4 * n); }
#pragma unroll
        for (int ai = 0; ai < 2; ++ai)
#pragma unroll
            for (int m = 0; m < 4; ++m) { const int rl = rl0 + ai * HALF + m * 16; const float rs = rs_list[(size_t)u.e * NTOK + u.r0 + rl];
                float a[8];
#pragma unroll
                for (int n = 0; n < 2; ++n)
#pragma unroll
                    for (int j = 0; j < 4; ++j) { float g = acc[ai][0][m][n][j] * rs + bgv[n][j], l = acc[ai][1][m][n][j] * rs + buv[n][j];
                        g = fminf(g, 7.0f); l = fminf(fmaxf(l, -7.0f), 7.0f);
                        const float sg = __builtin_amdgcn_rcpf(1.0f + __builtin_amdgcn_exp2f(g * (-1.702f * LOG2E)));
                        a[n * 4 + j] = g * sg * (l + 1.0f); }
                u32x4 w; w.x = cvt_pk_bf16(a[0], a[1]); w.y = cvt_pk_bf16(a[2], a[3]); w.z = cvt_pk_bf16(a[4], a[5]); w.w = cvt_pk_bf16(a[6], a[7]);
                *(u32x4*)(ACT + (size_t)(u.pm * BM + rl) * DEXP + colt) = w; }
    }
};
struct EpiDown {
    static constexpr bool PERM = true;
    bf16_t* Y0; bf16_t* Y1; const float* bd; const float* gate_list; const int* dst_list;
    __device__ __forceinline__ void operator()(const f32x4 (&acc)[2][2][4][2], const Unit& u, int wr, int wc, int fr, int fq) const {
        const int rl0 = wr * 64 + fr, colt = u.pn * BM + wc * 32 + 8 * fq;
        f32x4 bv[2][2];
#pragma unroll
        for (int bj = 0; bj < 2; ++bj)
#pragma unroll
            for (int n = 0; n < 2; ++n) bv[bj][n] = *(const f32x4*)(bd + (size_t)u.e * DM + colt + bj * HALF + 4 * n);
#pragma unroll
        for (int ai = 0; ai < 2; ++ai)
#pragma unroll
            for (int m = 0; m < 4; ++m) { const int rl = rl0 + ai * HALF + m * 16;
                if (rl < u.nv) { const size_t li = (size_t)u.e * NTOK + u.r0 + rl; const float gt = gate_list[li]; const int dst = dst_list[li];
                    const unsigned long long p0 = (unsigned long long)Y0, p1 = (unsigned long long)Y1, msk = 0ull - (unsigned long long)((dst >> 1) & 1);
                    __attribute__((address_space(1))) bf16_t* rowp = (__attribute__((address_space(1))) bf16_t*)(p0 ^ ((p0 ^ p1) & msk)) + ((size_t)(dst >> 2) * 2 + (dst & 1)) * DM + colt;
#pragma unroll
                    for (int bj = 0; bj < 2; ++bj) { const f32x4 v0 = (acc[ai][bj][m][0] + bv[bj][0]) * gt, v1 = (acc[ai][bj][m][1] + bv[bj][1]) * gt;
                        u32x4 w; w.x = cvt_pk_bf16(v0[0], v0[1]); w.y = cvt_pk_bf16(v0[2], v0[3]); w.z = cvt_pk_bf16(v1[0], v1[1]); w.w = cvt_pk_bf16(v1[2], v1[3]);
                        *(__attribute__((address_space(1))) u32x4*)(rowp + bj * HALF) = w; } } }
    }
};

template <class Epi, class Sched>
__device__ __forceinline__ void gemm_phase(PG8_LAS unsigned char* lds, const bf16_t* Abase, const int K, const Sched& S, const Epi& E) {
    int tid = threadIdx.x; asm volatile("" : "+v"(tid));
    const int wid = __builtin_amdgcn_readfirstlane(tid >> 6), lane = tid & 63, wr = wid >> 2, wc = wid & 3, fr = lane & 15, fq = lane >> 4;
    const int nt = K / BK;
    unsigned voffA[2], voffB[2];
#pragma unroll
    for (int i = 0; i < 2; ++i) { int R, C; stage_rc(tid * 16 + i * 8192, R, C); const int Rb = Epi::PERM ? ((R & ~31) + perm32(R & 31)) : R; voffA[i] = (unsigned)(R * K + C) * 2u; voffB[i] = (unsigned)(Rb * K + C) * 2u; }
    const size_t kstep = (size_t)(BK * 2);
    const size_t hstep = (size_t)HALF * K * 2;
    const unsigned ldsw = (unsigned)wid * 1024u;
    const int aoff = lds_byte(wr * 64 + fr, fq * 8), boff = lds_byte(wc * 32 + fr, fq * 8);
#define PG8_SA(b, h) (((b) * 2 + (h)) * HTB)
#define PG8_SB(b, h) ((4 + (b) * 2 + (h)) * HTB)
#define PG8_STAGE(bufoff, gbase, voff) do { _Pragma("unroll") for (int _i = 0; _i < 2; ++_i) \
        __builtin_amdgcn_global_load_lds((const unsigned*)((const char*)(gbase) + (voff)[_i]), (PG8_LAS unsigned*)(lds + (bufoff) + ldsw + _i * 8192), 16, 0, 0); } while (0)
#define PG8_LDA(dst, b, h) do { _Pragma("unroll") for (int m = 0; m < 4; ++m) _Pragma("unroll") for (int k = 0; k < 2; ++k) dst[m][k] = *(const PG8_LAS bf16x8*)(lds + PG8_SA(b, h) + aoff + m * 2048 + k * 1024); } while (0)
#define PG8_LDB(dst, b, h) do { _Pragma("unroll") for (int n = 0; n < 2; ++n) _Pragma("unroll") for (int k = 0; k < 2; ++k) dst[n][k] = *(const PG8_LAS bf16x8*)(lds + PG8_SB(b, h) + boff + n * 2048 + k * 1024); } while (0)
#define PG8_MMA(ai, bj, At, Bt) do { __builtin_amdgcn_s_setprio(1); _Pragma("unroll") for (int m = 0; m < 4; ++m) _Pragma("unroll") for (int n = 0; n < 2; ++n) _Pragma("unroll") for (int k = 0; k < 2; ++k) \
        acc[ai][bj][m][n] = __builtin_amdgcn_mfma_f32_16x16x32_bf16(Bt[n][k], At[m][k], acc[ai][bj][m][n], 0, 0, 0); __builtin_amdgcn_s_setprio(0); } while (0)
#define PG8_WAIT_V(n) asm volatile("s_waitcnt vmcnt(" #n ")" ::: "memory")
#define PG8_WAIT_L(n) asm volatile("s_waitcnt lgkmcnt(" #n ")" ::: "memory")
#define PG8_BAR __builtin_amdgcn_s_barrier()
#define PG8_SCHED __builtin_amdgcn_sched_barrier(0)
    Unit cur, nxt; int ui = 0;
    if (!S.next(0, cur)) return;
    f32x4 acc[2][2][4][2];
#pragma unroll
    for (int a = 0; a < 2; ++a)
#pragma unroll
        for (int b = 0; b < 2; ++b)
#pragma unroll
            for (int m = 0; m < 4; ++m)
#pragma unroll
                for (int n = 0; n < 2; ++n) acc[a][b][m][n] = (f32x4){0.f, 0.f, 0.f, 0.f};
    bf16x8 At[4][2], B0[2][2], B1[2][2];
    unsigned ca[2][2], na[2][2];
    S.aoffs(cur, tid, ca);
    const char* const Ab = (const char*)Abase;
    const char* cA = Ab + S.abase(cur);
    const char* cB = S.bbase(cur);
#define PG8_STAGE_A(bufoff, kb, h, nx) do { if constexpr (Sched::GATHER) { if (nx) PG8_STAGE(bufoff, Ab + (kb), na[h]); else PG8_STAGE(bufoff, Ab + (kb), ca[h]); } \
        else PG8_STAGE(bufoff, ((nx) ? nA : cA) + (kb) + (h) * hstep, voffA); } while (0)
    const char* nA = cA;
    PG8_STAGE(PG8_SB(0, 0), cB, voffB); PG8_STAGE(PG8_SB(0, 1), cB + hstep, voffB); PG8_STAGE_A(PG8_SA(0, 0), 0, 0, false); PG8_STAGE_A(PG8_SA(0, 1), 0, 1, false);
    if (wr == 1) PG8_BAR;
    PG8_WAIT_V(2); PG8_BAR;
    PG8_STAGE(PG8_SB(1, 0), cB + kstep, voffB); PG8_STAGE_A(PG8_SA(1, 0), kstep, 0, false); PG8_STAGE(PG8_SB(1, 1), cB + hstep + kstep, voffB);
    PG8_WAIT_V(6); PG8_BAR;
    for (;;) {
        const bool has_next = S.next(ui + 1, nxt);
        if (has_next) S.aoffs(nxt, tid, na);
        else {
#pragma unroll
            for (int h = 0; h < 2; ++h)
#pragma unroll
                for (int i = 0; i < 2; ++i) na[h][i] = ca[h][i];
        }
        nA = has_next ? Ab + S.abase(nxt) : cA;
        const char* nB = has_next ? S.bbase(nxt) : cB;
        for (int t = 0; t < nt; t += 2) {
            const bool last = (t == nt - 2);
            const size_t k1 = (size_t)(t + 1) * kstep, k2 = last ? (size_t)0 : (size_t)(t + 2) * kstep, k3 = k2 + kstep;
            const char* b2 = last ? nB : cB + (size_t)(t + 2) * kstep; const char* b3 = b2 + kstep;
            PG8_LDB(B0, 0, 0); PG8_LDB(B1, 0, 1); PG8_SCHED; PG8_LDA(At, 0, 0); PG8_STAGE_A(PG8_SA(1, 1), k1, 1, false);
            PG8_WAIT_V(8); PG8_WAIT_L(0); PG8_BAR; PG8_MMA(0, 0, At, B0); PG8_MMA(0, 1, At, B1); PG8_BAR; PG8_SCHED;
            PG8_LDA(At, 0, 1); PG8_STAGE(PG8_SB(0, 0), b2, voffB); PG8_STAGE(PG8_SB(0, 1), b2 + hstep, voffB); PG8_STAGE_A(PG8_SA(0, 0), k2, 0, last);
            PG8_WAIT_V(8); PG8_WAIT_L(0); PG8_BAR; PG8_MMA(1, 0, At, B0); PG8_MMA(1, 1, At, B1); PG8_BAR; PG8_SCHED;
            PG8_LDB(B0, 1, 0); PG8_LDB(B1, 1, 1); PG8_SCHED; PG8_LDA(At, 1, 0); PG8_STAGE_A(PG8_SA(0, 1), k2, 1, last);
            PG8_WAIT_V(8); PG8_WAIT_L(0); PG8_BAR; PG8_MMA(0, 0, At, B0); PG8_MMA(0, 1, At, B1); PG8_BAR; PG8_SCHED;
            PG8_LDA(At, 1, 1); PG8_STAGE(PG8_SB(1, 0), b3, voffB); PG8_STAGE(PG8_SB(1, 1), b3 + hstep, voffB); PG8_STAGE_A(PG8_SA(1, 0), k3, 0, last);
            PG8_WAIT_V(8); PG8_WAIT_L(0); PG8_BAR; PG8_MMA(1, 0, At, B0); PG8_MMA(1, 1, At, B1); PG8_BAR; PG8_SCHED;
        }
        if (wr == 0) PG8_BAR;
        E(acc, cur, wr, wc, fr, fq);
        if (!has_next) break;
#pragma unroll
        for (int a = 0; a < 2; ++a)
#pragma unroll
            for (int b = 0; b < 2; ++b)
#pragma unroll
                for (int m = 0; m < 4; ++m)
#pragma unroll
                    for (int n = 0; n < 2; ++n) acc[a][b][m][n] = (f32x4){0.f, 0.f, 0.f, 0.f};
        cur = nxt; cB = nB; cA = nA; ++ui;
#pragma unroll
        for (int h = 0; h < 2; ++h)
#pragma unroll
            for (int i = 0; i < 2; ++i) ca[h][i] = na[h][i];
        if (wr == 1) PG8_BAR;
    }
    PG8_WAIT_V(0);
    PG8_BAR;
#undef PG8_SA
#undef PG8_SB
#undef PG8_STAGE
#undef PG8_STAGE_A
#undef PG8_LDA
#undef PG8_LDB
#undef PG8_MMA
#undef PG8_WAIT_V
#undef PG8_WAIT_L
#undef PG8_BAR
#undef PG8_SCHED
}
}

typedef unsigned short bf16;
typedef unsigned v4u __attribute__((ext_vector_type(4)));
typedef unsigned v2u __attribute__((ext_vector_type(2)));
typedef float f32x4 __attribute__((ext_vector_type(4)));
typedef float f32x16 __attribute__((ext_vector_type(16)));
typedef short bf16x8 __attribute__((ext_vector_type(8)));
typedef short s16x4 __attribute__((ext_vector_type(4)));
typedef GAS unsigned gu32;
#define RLX_AGENT __ATOMIC_RELAXED, __HIP_MEMORY_SCOPE_AGENT
#define LDS_WAIT() asm volatile("s_waitcnt lgkmcnt(0)" ::: "memory")
#define VM_WAIT() asm volatile("s_waitcnt vmcnt(0)" ::: "memory")
__device__ __forceinline__ unsigned f2bf(float f) { unsigned u = __builtin_bit_cast(unsigned, f); return (u + 0x7fffu + ((u >> 16) & 1u)) >> 16; }
__device__ __forceinline__ unsigned pk2(float lo, float hi) { return f2bf(lo) | (f2bf(hi) << 16); }
__device__ __forceinline__ float bflo(unsigned u) { return __builtin_bit_cast(float, u << 16); }
__device__ __forceinline__ float bfhi(unsigned u) { return __builtin_bit_cast(float, u & 0xffff0000u); }

#define XB_TMO      128
#define XB_XCNT(j)  (256  + 64 * (j))
#define XB_XSUB(j)  (1280 + 64 * (j))
#define XB_XGEN(j)  (2304 + 64 * (j))
#define XB_TOP      3328
#define XB_TOPGEN   3392
#define XCD_BAR_WORDS 3456
#define XB_SPIN_CAP (1u << 18)
__device__ __forceinline__ unsigned xb_ld(unsigned* p)              { return __hip_atomic_load(p, __ATOMIC_RELAXED, __HIP_MEMORY_SCOPE_AGENT); }
__device__ __forceinline__ unsigned xb_add(unsigned* p, unsigned v) { return __hip_atomic_fetch_add(p, v, __ATOMIC_RELAXED, __HIP_MEMORY_SCOPE_AGENT); }
__device__ __forceinline__ unsigned xb_xcc_id() { return (unsigned)__builtin_amdgcn_s_getreg((3 << 11) | 20) & 0xFu; }
#define XB_SPIN(cond, bar) do { unsigned _sp = 0; while (cond) { __builtin_amdgcn_s_sleep(1); \
    if ((++_sp & 255u) == 0u) { if (xb_ld(&(bar)[XB_TMO])) break; if (_sp > XB_SPIN_CAP) { atomicAdd(&(bar)[XB_TMO], 1u); break; } } } } while (0)
struct XcdBarrier { unsigned* bar; unsigned x; volatile LAS unsigned* st; };
__device__ __forceinline__ XcdBarrier xcd_barrier_post(unsigned* bar, volatile LAS unsigned* st) {
    XcdBarrier b; b.bar = bar; b.x = xb_xcc_id(); b.st = st;
    if (threadIdx.x == 0) (void)xb_add(&bar[XB_XCNT(b.x)], 1u);
    return b;
}
__device__ __forceinline__ void xcd_barrier_complete(unsigned* bar, unsigned x, unsigned& nloc, unsigned& nx) {
    const unsigned G = gridDim.x * gridDim.y * gridDim.z;
    unsigned sum, cnt, mine, sp = 0u;
    for (;;) {
        sum = 0u; cnt = 0u; mine = 0u;
#pragma unroll
        for (unsigned j = 0; j < 16; ++j) { const unsigned c = xb_ld(&bar[XB_XCNT(j)]); sum += c; cnt += (c > 0u) ? 1u : 0u; mine = (j == x) ? c : mine; }
        if (sum == G) break;
        __builtin_amdgcn_s_sleep(1);
        if ((++sp & 255u) == 0u) { if (xb_ld(&bar[XB_TMO])) break; if (sp > XB_SPIN_CAP) { atomicAdd(&bar[XB_TMO], 1u); break; } }
    }
    nloc = mine > 0u ? mine : 1u; nx = cnt > 0u ? cnt : 1u;
}
__device__ __forceinline__ void xcd_barrier(const XcdBarrier& b) {
    asm volatile("s_waitcnt vmcnt(0)" ::: "memory");
    __syncthreads();
    if (threadIdx.x == 0) {
        unsigned* bar = b.bar;
        __builtin_amdgcn_s_waitcnt(0);
        unsigned nloc = b.st[0], nx = b.st[1];
        if (nloc == 0u) { xcd_barrier_complete(bar, b.x, nloc, nx); b.st[0] = nloc; b.st[1] = nx; }
        const unsigned old = xb_add(&bar[XB_XSUB(b.x)], 1u);
        const unsigned gen = old / nloc;
        if (old + 1u == (gen + 1u) * nloc) {
            __builtin_amdgcn_fence(__ATOMIC_RELEASE, "agent");
            asm volatile("s_waitcnt vmcnt(0)" ::: "memory");
            const unsigned og = xb_add(&bar[XB_TOP], 1u);
            const unsigned tg = og / nx;
            if (og + 1u == (tg + 1u) * nx) xb_add(&bar[XB_TOPGEN], 1u);
            else XB_SPIN(xb_ld(&bar[XB_TOPGEN]) == tg, bar);
            __builtin_amdgcn_fence(__ATOMIC_ACQUIRE, "agent");
            xb_add(&bar[XB_XGEN(b.x)], 1u);
            asm volatile("s_waitcnt vmcnt(0)" ::: "memory");
        } else {
            XB_SPIN(xb_ld(&bar[XB_XGEN(b.x)]) == gen, bar);
            __builtin_amdgcn_fence(__ATOMIC_ACQUIRE, "agent");
            asm volatile("s_waitcnt vmcnt(0)" ::: "memory");
        }
    }
    __syncthreads();
}

constexpr size_t MiB = 1u << 20;
constexpr size_t WS_CTL = 0, CTL_ZERO_BYTES = 1 * MiB;
constexpr size_t WS_WQKV = 1 * MiB;
constexpr size_t WS_WO = 7 * MiB;
constexpr size_t WS_WD = 9 * MiB;
constexpr size_t WS_TOK = 73 * MiB;
constexpr size_t WS_GATE = 81 * MiB;
constexpr size_t WS_RS = 89 * MiB;
constexpr size_t WS_DST = 97 * MiB;
constexpr size_t WS_X1B = 105 * MiB;
constexpr size_t WS_BIG = 233 * MiB;
constexpr size_t WS_XN = WS_BIG, WS_O = WS_BIG, WS_QKV = WS_BIG + 128 * MiB, WS_ACT = WS_BIG;
constexpr size_t WS_WGU = WS_BIG + 528 * MiB;
constexpr size_t WS_Y1 = WS_WGU;
constexpr size_t WS_END = WS_Y1 + 256 * MiB;
static_assert(WS_QKV + (size_t)NTOK * NQKV * 2 <= WS_WGU && WS_ACT + (size_t)NSLOT * DEXP * 2 <= WS_WGU && WS_END <= 1024 * MiB, "d_ws map");
constexpr int CW_CNT = 64;
constexpr int CW_BAR = 4096;

constexpr int RING_BYTES = 131072;
constexpr int MISC_OFF = RING_BYTES + 320;
constexpr int HIST_OFF = RING_BYTES + 512, BASE_OFF = RING_BYTES + 640, CNTL_OFF = RING_BYTES + 768, FIRST_OFF = RING_BYTES + 896, RBTAB_OFF = RING_BYTES + 1152;
constexpr int LDS_BYTES = 147456;
static_assert(RBTAB_OFF + MAXRB * 4 <= LDS_BYTES, "LDS map");

struct Args { const float* in[17]; float* out; unsigned char* ws; };

__device__ __forceinline__ float wave_sum(float v) {
#pragma unroll
    for (int o = 1; o < 64; o <<= 1) v += __shfl_xor(v, o);
    return v;
}
__device__ __forceinline__ int crow(int r, int hi) { return (r & 3) + 8 * (r >> 2) + 4 * hi; }

__device__ __forceinline__ void p0_transpose_item(const float* W, int N, bf16* WT, int K, const float* gk, float sn, LAS float* scr, int k0, int n0, int lane) {
#pragma unroll 8
    for (int i = 0; i < 32; ++i) { const int kk = 2 * i + (lane >> 5); float v = W[(size_t)(k0 + kk) * N + n0 + (lane & 31)] * sn; if (gk) v *= gk[k0 + kk]; scr[kk * 33 + (lane & 31)] = v; }
    LDS_WAIT(); asm volatile("" ::: "memory");
    const int c = lane & 7;
#pragma unroll
    for (int j = 0; j < 4; ++j) { const int n = (lane >> 3) + 8 * j; const LAS float* s = scr + (8 * c) * 33 + n;
        v4u o; o.x = pk2(s[0 * 33], s[1 * 33]); o.y = pk2(s[2 * 33], s[3 * 33]); o.z = pk2(s[4 * 33], s[5 * 33]); o.w = pk2(s[6 * 33], s[7 * 33]);
        *(GAS v4u*)(WT + (size_t)n * K + k0 + 8 * c) = o; }
    LDS_WAIT(); asm volatile("" ::: "memory");
}

template <int B> __device__ __forceinline__ bf16x8 pack8(const f32x16& p) {
    v4u w; w.x = pg8::cvt_pk_bf16(p[B + 0], p[B + 1]); w.y = pg8::cvt_pk_bf16(p[B + 2], p[B + 3]); w.z = pg8::cvt_pk_bf16(p[B + 4], p[B + 5]); w.w = pg8::cvt_pk_bf16(p[B + 6], p[B + 7]);
    return __builtin_bit_cast(bf16x8, w);
}
typedef short v4i16_t __attribute__((ext_vector_type(4)));
__device__ __forceinline__ s16x4 vtr(const LAS unsigned char* p) { return __builtin_bit_cast(s16x4, __builtin_amdgcn_ds_read_tr16_b64_v4i16((LAS v4i16_t*)p)); }

__device__ __forceinline__ f32x16 qk_tile(const bf16* krow  , const bf16x8 (&qf)[4], int hi) {
    bf16x8 kf[4];
#pragma unroll
    for (int d0 = 0; d0 < 4; ++d0) kf[d0] = *(const bf16x8*)(krow + d0 * 16 + hi * 8);
    f32x16 p = {};
#pragma unroll
    for (int d0 = 0; d0 < 4; ++d0) p = __builtin_amdgcn_mfma_f32_32x32x16_bf16(kf[d0], qf[d0], p, 0, 0, 0);
    return p;
}
__device__ __forceinline__ void v_stage(LAS unsigned char* vst, const bf16* const (&vrow)[2]  , int lane) {
    v4u t[4];
#pragma unroll
    for (int i = 0; i < 4; ++i) t[i] = *(const v4u*)(vrow[i & 1] + (4 * (i >> 1) + (lane & 3)) * 8);
#pragma unroll
    for (int i = 0; i < 4; ++i) *(LAS v4u*)(vst + i * 1024 + lane * 16) = t[i];
}
__device__ __forceinline__ void pv_tile(f32x16 (&o)[2], const LAS unsigned char* vst, const bf16x8 (&pa)[2], int lane) {
    const int hi = lane >> 5, blk = (lane >> 4) & 1, qq = (lane & 15) >> 2, p = lane & 3;
    const LAS unsigned char* vb = vst + (4 * hi + qq) * 64 + blk * 32 + p * 8;
#pragma unroll
    for (int c = 0; c < 2; ++c)
#pragma unroll
        for (int ks = 0; ks < 2; ++ks) {
            const s16x4 lo = vtr(vb + c * 2048 + (16 * ks) * 64), hh = vtr(vb + c * 2048 + (16 * ks + 8) * 64);
            const bf16x8 vf = (bf16x8){lo[0], lo[1], lo[2], lo[3], hh[0], hh[1], hh[2], hh[3]};
            o[c] = __builtin_amdgcn_mfma_f32_32x32x16_bf16(vf, pa[ks], o[c], 0, 0, 0);
        }
}
__device__ __forceinline__ void attn_store(f32x16 (&o)[2], float inv, LAS float* xs  , bf16* orow  , int wid, int lane) {
    const int r32 = lane & 31, hi = lane >> 5;
    float ss = 0.f;
#pragma unroll
    for (int c = 0; c < 2; ++c)
#pragma unroll
        for (int r = 0; r < 16; ++r) { o[c][r] *= inv; ss += o[c][r] * o[c][r]; }
    ss += __shfl_xor(ss, 32);
    if (hi == 0) xs[wid * 32 + r32] = ss;
    LDS_WAIT(); __builtin_amdgcn_s_barrier(); asm volatile("" ::: "memory");
    float tot = 0.f;
#pragma unroll
    for (int w = 0; w < 8; ++w) tot += xs[w * 32 + r32];
    const float rstd = 1.0f / sqrtf(tot * (1.0f / 512.0f) + RMS_EPS);
#pragma unroll
    for (int c = 0; c < 2; ++c)
#pragma unroll
        for (int g = 0; g < 4; ++g) { v2u w; w.x = pg8::cvt_pk_bf16(o[c][4 * g] * rstd, o[c][4 * g + 1] * rstd); w.y = pg8::cvt_pk_bf16(o[c][4 * g + 2] * rstd, o[c][4 * g + 3] * rstd);
            *(v2u*)(orow + 32 * c + 8 * g + 4 * hi) = w; }
}

__global__ void __launch_bounds__(512, 2) hybrid_fwd(Args args) {
    extern __shared__ __attribute__((aligned(16))) unsigned char lds_raw[];
    LAS unsigned char* lds = (LAS unsigned char*)lds_raw;
    volatile LAS unsigned* MISC = (volatile LAS unsigned*)(lds + MISC_OFF);
    const int tid = threadIdx.x, lane = tid & 63, wid = __builtin_amdgcn_readfirstlane(tid >> 6);
    const int G = gridDim.x, bx = blockIdx.x;
    const int vcu = (G % 8 == 0) ? (bx % 8) * (G / 8) + bx / 8 : bx;
    unsigned char* ws = args.ws;
    unsigned* ctl = (unsigned*)(ws + WS_CTL);
    const float* x = args.in[0]; const float* g_attn = args.in[1]; const float* w_qkv = args.in[2]; const float* rel_bias = args.in[3];
    const float* g_out_dil = args.in[4]; const float* g_out_sb = args.in[5]; const float* w_o = args.in[6]; const float* g_moe = args.in[7];
    const float* w_router = args.in[8]; const float* b_router = args.in[9]; const float* w_gate = args.in[10]; const float* b_gate = args.in[11];
    const float* w_up = args.in[12]; const float* b_up = args.in[13]; const float* w_down = args.in[14]; const float* b_down = args.in[15]; const float* g_final = args.in[16];
    float* out = args.out;
    bf16* Wqkv_t = (bf16*)(ws + WS_WQKV); bf16* Wo_t = (bf16*)(ws + WS_WO); bf16* Wd_t = (bf16*)(ws + WS_WD); bf16* Wgu_t = (bf16*)(ws + WS_WGU);
    bf16* XN = (bf16*)(ws + WS_XN); bf16* QKV = (bf16*)(ws + WS_QKV); bf16* OB = (bf16*)(ws + WS_O); bf16* X1B = (bf16*)(ws + WS_X1B);
    bf16* ACT = (bf16*)(ws + WS_ACT); bf16* Y1 = (bf16*)(ws + WS_Y1); bf16* Y0 = (bf16*)out;
    int* tok_list = (int*)(ws + WS_TOK); float* gate_list = (float*)(ws + WS_GATE); float* rs_list = (float*)(ws + WS_RS); int* dst_list = (int*)(ws + WS_DST);
    unsigned* cnt_g = ctl + CW_CNT;

    for (int u = tid; u < (LDS_BYTES - RING_BYTES) / 4; u += 512) ((LAS unsigned*)(lds + RING_BYTES))[u] = 0u;
    __syncthreads();
    XcdBarrier bar = xcd_barrier_post(ctl + CW_BAR, MISC + 8);
    const int gw = vcu * 8 + wid, NGW = G * 8;

    {
        LAS float* scr = (LAS float*)(lds + wid * 16384);
        constexpr int I_QKV = 16 * 96, I_O = 16 * 32, I_E = 3 * 16 * 32, NITEMS = I_QKV + I_O + NEXP * I_E;
        for (int it = gw; it < NITEMS; it += NGW) {
            int r = it;
            if (r < I_QKV) { const int kb = r / 96, nb = r % 96, n0 = 32 * nb; const float sn = (n0 < 512 || (n0 >= 1536 && n0 < 2048)) ? QSCALE : 1.0f;
                p0_transpose_item(w_qkv, NQKV, Wqkv_t + (size_t)n0 * DM, DM, g_attn, sn, scr, 64 * kb, n0, lane); continue; }
            r -= I_QKV;
            if (r < I_O) { const int kb = r / 32, nb = r % 32, n0 = 32 * nb, k0 = 64 * kb;
                p0_transpose_item(w_o, DM, Wo_t + (size_t)n0 * DM, DM, (k0 < 512) ? g_out_dil : (g_out_sb - 512), 1.0f, scr, k0, n0, lane); continue; }
            r -= I_O;
            const int e = r / I_E, q = r % I_E, m = q / 512, qq = q % 512, kb = qq / 32, nb = qq % 32, n0 = 32 * nb, k0 = 64 * kb;
            if (m < 2) { const float* src = (m == 0 ? w_gate : w_up) + (size_t)e * DM * DEXP;
                bf16* dst = Wgu_t + ((size_t)e * 2048 + (n0 >> 7) * 256 + m * 128 + (n0 & 127)) * DM;
                p0_transpose_item(src, DEXP, dst, DM, g_moe, 1.0f, scr, k0, n0, lane); }
            else { const float* src = w_down + (size_t)e * DEXP * DM; bf16* dst = Wd_t + ((size_t)e * DM + n0) * DEXP;
                p0_transpose_item(src, DM, dst, DEXP, nullptr, 1.0f, scr, k0, n0, lane); }
        }
        for (int m = gw; m < NTOK; m += NGW) {
            const GAS f32x4* xr = (const GAS f32x4*)(x + (size_t)m * DM) + lane;
            f32x4 v[4]; float s2 = 0.f;
#pragma unroll
            for (int j = 0; j < 4; ++j) { v[j] = xr[64 * j]; s2 += (v[j].x * v[j].x + v[j].y * v[j].y) + (v[j].z * v[j].z + v[j].w * v[j].w); }
            const float rstd = 1.0f / sqrtf(wave_sum(s2) * (1.0f / DM) + RMS_EPS);
            GAS unsigned long long* o8 = (GAS unsigned long long*)(XN + (size_t)m * DM) + lane;
#pragma unroll
            for (int j = 0; j < 4; ++j) o8[64 * j] = (unsigned long long)pk2(v[j].x * rstd, v[j].y * rstd) | ((unsigned long long)pk2(v[j].z * rstd, v[j].w * rstd) << 32);
        }
    }
    xcd_barrier(bar);

    {
        pg8::DenseOrder S; S.init(NTOK, NQKV, DM, G, bx, Wqkv_t);
        pg8::EpiQKV E{QKV, NQKV};
        pg8::gemm_phase<pg8::EpiQKV, pg8::DenseOrder>(lds, XN, DM, S, E);
    }
    xcd_barrier(bar);

    {
        LAS float* btab = (LAS float*)lds;
        LAS float* xsb = (LAS float*)(lds + 12800);
        LAS unsigned char* vst = lds + 16384 + wid * 4096;
        for (int i = tid; i < 3 * 8 * 129; i += 512) {
            const int p = i / (8 * 129), rem = i % (8 * 129), h = rem / 129, j = rem % 129;
            const int dist = j << (2 * p);
            int bkt = dist;
            if (dist >= 16) bkt = 16 + (dist >= 22) + (dist >= 30) + (dist >= 40) + (dist >= 54) + (dist >= 73) + (dist >= 99) + (dist >= 134) + (dist >= 182) + (dist >= 246)
                                     + (dist >= 332) + (dist >= 450) + (dist >= 609) + (dist >= 825) + (dist >= 1117) + (dist >= 1513);
            btab[(p * 8 + h) * 132 + j] = rel_bias[bkt * 8 + h] * LOG2E;
        }
        __syncthreads();
        const int r32 = lane & 31, hi = lane >> 5, h = wid;
        int par = 0;
        for (int item = vcu; item < BATCH * 16 * 16; item += G, par ^= 1) {
            const int b = item >> 8, ch = (item >> 4) & 15, rho = item & 15;
            const int qpos = 512 * ch + rho + 16 * r32;
            const bf16* base = QKV + (size_t)b * SEQ * NQKV;
            bf16x8 qf[4];
#pragma unroll
            for (int d0 = 0; d0 < 4; ++d0) qf[d0] = *(const bf16x8*)(base + (size_t)qpos * NQKV + h * 64 + d0 * 16 + hi * 8);
            f32x16 o[2]; o[0] = f32x16{}; o[1] = f32x16{};
            float m_run = -1e30f, l_run = 0.f;
#pragma unroll 1
            for (int p = 0; p < 3; ++p) {
                const int sh = 2 * p, dl = 1 << sh, ntile = (p == 0) ? 20 : (p == 1 ? 8 : 5);
                const int lo = 512 * ch + rho - 128 * dl;
                const LAS float* bt = btab + (p * 8 + h) * 132;
#pragma unroll 1
                for (int kt = 0; kt < ntile; ++kt) {
                    const int kbase = lo + dl * 32 * kt;
                    if (kbase + dl * 31 < 0) continue;
                    int kp = kbase + dl * r32; kp = kp < 0 ? 0 : (kp > SEQ - 1 ? SEQ - 1 : kp);
                    f32x16 s = qk_tile(base + (size_t)kp * NQKV + 512 + h * 64, qf, hi);
                    const bf16* vrow[2];
#pragma unroll
                    for (int i = 0; i < 2; ++i) { int vp = kbase + dl * (16 * i + (lane >> 2)); vp = vp < 0 ? 0 : (vp > SEQ - 1 ? SEQ - 1 : vp); vrow[i] = base + (size_t)vp * NQKV + 1024 + h * 64; }
                    v_stage(vst, vrow, lane);
                    f32x16 pe; bool ok[16]; float mx = -1e30f;
#pragma unroll
                    for (int r = 0; r < 16; ++r) { const int kpos = kbase + dl * crow(r, hi), dist = qpos - kpos; ok[r] = (kpos >= 0) && (dist >= 0) && (dist <= 128 * dl);
                        int j = dist >> sh; j = j < 0 ? 0 : (j > 128 ? 128 : j);
                        pe[r] = s[r] + bt[j]; mx = fmaxf(mx, ok[r] ? pe[r] : -1e30f); }
                    mx = fmaxf(mx, __shfl_xor(mx, 32));
                    const float m_new = fmaxf(m_run, mx), f = __builtin_amdgcn_exp2f(m_run - m_new);
                    m_run = m_new; l_run *= f;
#pragma unroll
                    for (int c = 0; c < 2; ++c)
#pragma unroll
                        for (int r = 0; r < 16; ++r) o[c][r] *= f;
#pragma unroll
                    for (int r = 0; r < 16; ++r) { pe[r] = ok[r] ? __builtin_amdgcn_exp2f(pe[r] - m_new) : 0.f; l_run += pe[r]; }
                    bf16x8 pa[2]; pa[0] = pack8<0>(pe); pa[1] = pack8<8>(pe);
                    pv_tile(o, vst, pa, lane);
                }
            }
            l_run += __shfl_xor(l_run, 32);
            attn_store(o, 1.0f / l_run, xsb + par * 256, OB + ((size_t)b * SEQ + qpos) * DM + h * 64, wid, lane);
        }
        bf16x8 Tm[2];
#pragma unroll
        for (int ks = 0; ks < 2; ++ks) { v4u w;
#pragma unroll
            for (int jj = 0; jj < 4; ++jj) { const unsigned a = (crow(8 * ks + 2 * jj, hi) >= r32) ? 0x3F80u : 0u, bq = (crow(8 * ks + 2 * jj + 1, hi) >= r32) ? 0x3F80u : 0u; w[jj] = a | (bq << 16); }
            Tm[ks] = __builtin_bit_cast(bf16x8, w); }
        for (int item = vcu; item < BATCH * (SEQ / 32); item += G, par ^= 1) {
            const int b = item >> 8, qt = item & 255, t0 = 32 * qt, qpos = t0 + r32;
            const bf16* base = QKV + (size_t)b * SEQ * NQKV;
            bf16x8 qf[4];
#pragma unroll
            for (int d0 = 0; d0 < 4; ++d0) qf[d0] = *(const bf16x8*)(base + (size_t)qpos * NQKV + 1536 + h * 64 + d0 * 16 + hi * 8);
            f32x16 o[2]; o[0] = f32x16{}; o[1] = f32x16{};
            float carry = 0.f;
#pragma unroll 1
            for (int k0 = t0; k0 >= 0; k0 -= 32) {
                f32x16 z = qk_tile(base + (size_t)(k0 + r32) * NQKV + 2048 + h * 64, qf, hi);
                const bf16* vrow[2];
#pragma unroll
                for (int i = 0; i < 2; ++i) vrow[i] = base + (size_t)(k0 + 16 * i + (lane >> 2)) * NQKV + 2560 + h * 64;
                v_stage(vst, vrow, lane);
                f32x16 sp; bool ok[16];
#pragma unroll
                for (int r = 0; r < 16; ++r) { ok[r] = (k0 + crow(r, hi)) < qpos; const float zz = z[r];
                    float v = __builtin_amdgcn_logf(1.0f + __builtin_amdgcn_exp2f(fminf(zz, 64.0f)));
                    v = zz > 30.0f ? zz : v; sp[r] = ok[r] ? v : 0.f; }
                bf16x8 sb[2]; sb[0] = pack8<0>(sp); sb[1] = pack8<8>(sp);
                f32x16 cs;
#pragma unroll
                for (int r = 0; r < 16; ++r) cs[r] = carry;
                cs = __builtin_amdgcn_mfma_f32_32x32x16_bf16(Tm[0], sb[0], cs, 0, 0, 0);
                cs = __builtin_amdgcn_mfma_f32_32x32x16_bf16(Tm[1], sb[1], cs, 0, 0, 0);
                f32x16 pe;
#pragma unroll
                for (int r = 0; r < 16; ++r) pe[r] = ok[r] ? __builtin_amdgcn_exp2f(z[r] - cs[r]) : 0.f;
                bf16x8 pa[2]; pa[0] = pack8<0>(pe); pa[1] = pack8<8>(pe);
                pv_tile(o, vst, pa, lane);
                carry = __shfl(cs[0], r32);
                if (__all(carry > 150.0f)) break;
            }
            attn_store(o, 1.0f, xsb + par * 256, OB + ((size_t)b * SEQ + qpos) * DM + 512 + h * 64, wid, lane);
        }
    }
    xcd_barrier(bar);

    {
        pg8::DenseOrder S; S.init(NTOK, DM, DM, G, bx, Wo_t);
        pg8::EpiWo E{x, out, X1B};
        pg8::gemm_phase<pg8::EpiWo, pg8::DenseOrder>(lds, OB, DM, S, E);
    }
    xcd_barrier(bar);

    {
        LAS float* Wl = (LAS float*)lds;
        LAS unsigned* hist = (LAS unsigned*)(lds + HIST_OFF); LAS unsigned* basel = (LAS unsigned*)(lds + BASE_OFF);
        for (int s = tid; s < DM * NEXP; s += 512) { const int k = s >> 5, e = s & 31; Wl[(((k >> 3) * 2 + ((k >> 2) & 1)) * 32 + e) * 4 + (k & 3)] = g_moe[k] * w_router[s]; }
        if (tid < 32) hist[tid] = 0u;
        __syncthreads();
        const int r32 = lane & 31, hi = lane >> 5;
        for (int chunk = bx; chunk < NTOK / 256; chunk += G) {
            const int row = chunk * 256 + wid * 32 + r32;
            const GAS f32x4* xr = (const GAS f32x4*)(out + (size_t)row * DM + 4 * hi);
            const LAS f32x4* wl = (const LAS f32x4*)Wl + hi * 32 + r32;
            f32x16 acc = {}; float ssq = 0.f;
#pragma unroll 4
            for (int i = 0; i < 128; ++i) { const f32x4 v = xr[2 * i]; const f32x4 w = wl[i * 64];
                acc = __builtin_amdgcn_mfma_f32_32x32x2f32(w.x, v.x, acc, 0, 0, 0); acc = __builtin_amdgcn_mfma_f32_32x32x2f32(w.y, v.y, acc, 0, 0, 0);
                acc = __builtin_amdgcn_mfma_f32_32x32x2f32(w.z, v.z, acc, 0, 0, 0); acc = __builtin_amdgcn_mfma_f32_32x32x2f32(w.w, v.w, acc, 0, 0, 0);
                ssq += (v.x * v.x + v.y * v.y) + (v.z * v.z + v.w * v.w); }
            ssq += __shfl_xor(ssq, 32);
            const float rstd2 = 1.0f / sqrtf(ssq * (1.0f / DM) + RMS_EPS);
            float lg[16];
#pragma unroll
            for (int r = 0; r < 16; ++r) lg[r] = acc[r] * rstd2 + b_router[crow(r, hi)];
            float tv[4]; int ti[4];
#pragma unroll
            for (int k = 0; k < 4; ++k) {
                float bv = lg[0]; int bi = crow(0, hi);
#pragma unroll
                for (int r = 1; r < 16; ++r) { if (lg[r] > bv) { bv = lg[r]; bi = crow(r, hi); } }
                const float pv = __shfl_xor(bv, 32); const int pi = __shfl_xor(bi, 32);
                const bool mine = (bv > pv) || (bv == pv && bi < pi);
                tv[k] = mine ? bv : pv; ti[k] = mine ? bi : pi;
#pragma unroll
                for (int r = 0; r < 16; ++r) if (mine && crow(r, hi) == bi) lg[r] = -3.0e38f;
            }
            float ge[4]; float gs = 0.f;
#pragma unroll
            for (int k = 0; k < 4; ++k) { ge[k] = __builtin_amdgcn_exp2f((tv[k] - tv[0]) * LOG2E); gs += ge[k]; }
            const float ginv = 1.0f / gs;
            unsigned rank[4] = {0u, 0u, 0u, 0u};
            if (hi == 0) {
#pragma unroll
                for (int k = 0; k < 4; ++k) rank[k] = __hip_atomic_fetch_add(hist + ti[k], 1u, __ATOMIC_RELAXED, __HIP_MEMORY_SCOPE_WORKGROUP);
            }
            __syncthreads();
            if (tid < 32) basel[tid] = __hip_atomic_fetch_add(cnt_g + tid, hist[tid], RLX_AGENT);
            __syncthreads();
            if (hi == 0) {
#pragma unroll
                for (int k = 0; k < 4; ++k) { const size_t li = (size_t)ti[k] * NTOK + basel[ti[k]] + rank[k];
                    tok_list[li] = row; gate_list[li] = ge[k] * ginv; rs_list[li] = rstd2; dst_list[li] = row * 4 + k; }
            }
            __syncthreads();
            if (tid < 32) hist[tid] = 0u;
            __syncthreads();
        }
    }
    xcd_barrier(bar);

    LAS int* cntl = (LAS int*)(lds + CNTL_OFF); LAS int* firstl = (LAS int*)(lds + FIRST_OFF); LAS int* rbtab = (LAS int*)(lds + RBTAB_OFF);
    if (tid < 64) {
        int c = 0; if (tid < 32) c = (int)__hip_atomic_load(cnt_g + tid, RLX_AGENT);
        const int nrb = (c + 255) >> 8; int inc = nrb;
#pragma unroll
        for (int o = 1; o < 32; o <<= 1) { const int t = __shfl_up(inc, o); if ((tid & 31) >= o) inc += t; }
        if (tid < 32) { cntl[tid] = c; firstl[tid] = inc - nrb; if (tid == 31) firstl[32] = inc; }
    }
    __syncthreads();
    const int nRB = firstl[32];
    for (int rb = tid; rb < nRB; rb += 512) { int e = 0;
#pragma unroll 1
        for (int q = 1; q < 32; ++q) e += (firstl[q] <= rb) ? 1 : 0;
        rbtab[rb] = (e << 16) | (rb - firstl[e]); }
    __syncthreads();

    {
        pg8::MoeOrder<true> S{G, bx, 8, nRB, DM, (const char*)Wgu_t, (size_t)2048 * DM * 2, rbtab, cntl, tok_list};
        pg8::EpiGU E{ACT, b_gate, b_up, rs_list};
        pg8::gemm_phase<pg8::EpiGU, pg8::MoeOrder<true>>(lds, X1B, DM, S, E);
    }
    xcd_barrier(bar);

    {
        pg8::MoeOrder<false> S{G, bx, 4, nRB, DEXP, (const char*)Wd_t, (size_t)DM * DEXP * 2, rbtab, cntl, nullptr};
        pg8::EpiDown E{Y0, Y1, b_down, gate_list, dst_list};
        pg8::gemm_phase<pg8::EpiDown, pg8::MoeOrder<false>>(lds, ACT, DEXP, S, E);
    }
    xcd_barrier(bar);

    {
        const f32x4 gf0 = *(const f32x4*)(g_final + 8 * lane), gf1 = *(const f32x4*)(g_final + 8 * lane + 4);
        const f32x4 gf2 = *(const f32x4*)(g_final + 512 + 8 * lane), gf3 = *(const f32x4*)(g_final + 512 + 8 * lane + 4);
        for (int m = gw; m < NTOK; m += NGW) {
            v4u a[2][5];
#pragma unroll
            for (int j = 0; j < 2; ++j) {
                a[j][0] = *(const GAS v4u*)(X1B + (size_t)m * DM + 512 * j + 8 * lane);
                a[j][1] = *(const GAS v4u*)(Y0 + ((size_t)m * 2 + 0) * DM + 512 * j + 8 * lane);
                a[j][2] = *(const GAS v4u*)(Y0 + ((size_t)m * 2 + 1) * DM + 512 * j + 8 * lane);
                a[j][3] = *(const GAS v4u*)(Y1 + ((size_t)m * 2 + 0) * DM + 512 * j + 8 * lane);
                a[j][4] = *(const GAS v4u*)(Y1 + ((size_t)m * 2 + 1) * DM + 512 * j + 8 * lane);
            }
            float v[2][8]; float s2 = 0.f;
#pragma unroll
            for (int j = 0; j < 2; ++j)
#pragma unroll
                for (int q = 0; q < 4; ++q) { float lo = 0.f, hh = 0.f;
#pragma unroll
                    for (int t = 0; t < 5; ++t) { lo += bflo(a[j][t][q]); hh += bfhi(a[j][t][q]); }
                    v[j][2 * q] = lo; v[j][2 * q + 1] = hh; s2 += lo * lo + hh * hh; }
            const float rstd = 1.0f / sqrtf(wave_sum(s2) * (1.0f / DM) + RMS_EPS);
            GAS f32x4* op = (GAS f32x4*)(out + (size_t)m * DM + 8 * lane);
            op[0] = (f32x4){v[0][0] * rstd * gf0.x, v[0][1] * rstd * gf0.y, v[0][2] * rstd * gf0.z, v[0][3] * rstd * gf0.w};
            op[1] = (f32x4){v[0][4] * rstd * gf1.x, v[0][5] * rstd * gf1.y, v[0][6] * rstd * gf1.z, v[0][7] * rstd * gf1.w};
            op[128] = (f32x4){v[1][0] * rstd * gf2.x, v[1][1] * rstd * gf2.y, v[1][2] * rstd * gf2.z, v[1][3] * rstd * gf2.w};
            op[129] = (f32x4){v[1][4] * rstd * gf3.x, v[1][5] * rstd * gf3.y, v[1][6] * rstd * gf3.z, v[1][7] * rstd * gf3.w};
        }
    }
}

extern "C" void kernel_launch(void* const* d_in, const int* in_sizes, int n_in, void* d_out, int out_size, void* d_ws, size_t ws_size, hipStream_t stream) {
    static int grid = 0;
    if (grid == 0) {
        if (n_in != 17 || out_size != NTOK * DM || ws_size < WS_END) { fprintf(stderr, "kernel_launch: unexpected shapes (n_in %d, out %d, ws %zu)\n", n_in, out_size, ws_size); grid = -1; return; }
        int dev = 0, cus = 0;
        if (hipGetDevice(&dev) != hipSuccess || hipDeviceGetAttribute(&cus, hipDeviceAttributeMultiprocessorCount, dev) != hipSuccess) { grid = -1; return; }
        if (hipFuncSetAttribute((const void*)hybrid_fwd, hipFuncAttributeMaxDynamicSharedMemorySize, LDS_BYTES) != hipSuccess) { grid = -1; return; }
        int per_cu = 0;
        if (hipOccupancyMaxActiveBlocksPerMultiprocessor(&per_cu, (const void*)hybrid_fwd, 512, LDS_BYTES) != hipSuccess || per_cu < 1) { fprintf(stderr, "kernel_launch: occupancy query says %d\n", per_cu); }
        (void)hipGetLastError();
        grid = cus;
    }
    if (grid < 0) return;
    if (hipMemsetAsync((char*)d_ws + WS_CTL, 0, CTL_ZERO_BYTES, stream) != hipSuccess) return;
    Args a{};
    for (int i = 0; i < 17; ++i) a.in[i] = (const float*)d_in[i];
    a.out = (float*)d_out; a.ws = (unsigned char*)d_ws;
    hipLaunchKernelGGL(hybrid_fwd, dim3(grid), dim3(512), LDS_BYTES, stream, a);
}
```

```cpp
#include <hip/hip_runtime.h>
#include <cstdio>
#include <cstdint>

#define GAS __attribute__((address_space(1)))
#define LAS __attribute__((address_space(3)))
#ifndef REP_P0
#define REP_P0 1
#endif
#ifndef REP_P1
#define REP_P1 1
#endif
#ifndef REP_A
#define REP_A 1
#endif
#ifndef REP_B
#define REP_B 1
#endif
#ifndef REP_P3
#define REP_P3 1
#endif
#ifndef REP_P5
#define REP_P5 1
#endif
#ifndef REP_P6
#define REP_P6 1
#endif
#ifndef KREP_P1
#define KREP_P1 1
#endif
#ifndef EREP_P1
#define EREP_P1 1
#endif
#ifndef REP_P1_UNITS
#define REP_P1_UNITS 12
#endif
#ifndef KREP_P5
#define KREP_P5 1
#endif

constexpr int BATCH = 8, SEQ = 8192, DM = 1024, NTOK = BATCH * SEQ;
constexpr int NQKV = 3072, NEXP = 32, TOPK = 4, DEXP = 1024;
constexpr int MAXRB = NTOK * TOPK / 256 + NEXP;
constexpr int NSLOT = MAXRB * 256;
constexpr float RMS_EPS = 1e-6f;
constexpr float LOG2E = 1.4426950408889634f;
constexpr float QSCALE = 0.125f * LOG2E;

namespace pg8 {
#define PG8_LAS __attribute__((address_space(3)))
typedef unsigned short bf16_t;
typedef short bf16x8 __attribute__((ext_vector_type(8)));
typedef float f32x4 __attribute__((ext_vector_type(4)));
typedef unsigned u32x4 __attribute__((ext_vector_type(4)));
typedef unsigned u32x2 __attribute__((ext_vector_type(2)));
constexpr int BM = 256, BK = 64, HALF = 128, HTB = HALF * BK * 2, STAGE_BYTES = 8 * HTB, NXCD = 8, WGM = 8;

__host__ __device__ __forceinline__ int lds_chunk(int r, int c) { return (r >> 3) * 1024 + (r & 7) * 128 + ((c ^ ((r >> 1) & 7)) << 4); }
__host__ __device__ __forceinline__ void stage_rc(int b, int& R, int& C) { R = (b >> 10) * 8 + ((b >> 7) & 7); C = ((((b >> 4) & 7) ^ ((R >> 1) & 7))) * 8; }
__host__ __device__ __forceinline__ int perm32(int rho) { const int n = rho >> 4, i = rho & 15; return 8 * (i >> 2) + 4 * n + (i & 3); }

__device__ __forceinline__ int lane_now() { unsigned z = 0u; asm volatile("" : "+s"(z)); return (int)__builtin_amdgcn_mbcnt_hi(~0u, __builtin_amdgcn_mbcnt_lo(~0u, z)); }
struct Unit { int pm, pn, e, r0, nv; };

typedef float f32x2_cv __attribute__((ext_vector_type(2))); typedef __bf16 bf16x2_cv __attribute__((ext_vector_type(2)));
__device__ __forceinline__ unsigned cvt_pk_bf16(float lo, float hi) { const f32x2_cv v = {lo, hi}; const bf16x2_cv b = __builtin_convertvector(v, bf16x2_cv); return __builtin_bit_cast(unsigned, b); }

struct DenseOrder {
    int nM, nN, nwg, G, c, K; const char* Bt; int maxi = 1 << 30;
    __device__ void init(int M, int N, int K_, int G_, int c_, const void* Bt_) { nM = M / BM; nN = N / BM; nwg = nM * nN; G = G_; c = c_; K = K_; Bt = (const char*)Bt_; }
    __device__ __forceinline__ bool next(int i, Unit& u) const {
        const long L = (long)i * G + c; if (L >= nwg || i >= maxi) return false;
        int wgid = (int)L; { const int q = nwg / NXCD, r = nwg % NXCD, xcd = wgid % NXCD, off = wgid / NXCD; wgid = (xcd < r ? xcd * (q + 1) : r * (q + 1) + (xcd - r) * q) + off; }
        const int nig = WGM * nN, gid = wgid / nig, fm = gid * WGM, gsz = (nM - fm) < WGM ? (nM - fm) : WGM;
        u.pm = fm + ((wgid % nig) % gsz); u.pn = (wgid % nig) / gsz; u.e = 0; u.r0 = 0; u.nv = 256; return true;
    }
    static constexpr bool GATHER = false;
    static constexpr int BPAD = 64;
    __device__ __forceinline__ const char* bbase(const Unit& u) const { return Bt + (size_t)u.pn * BM * (K + BPAD) * 2; }
    __device__ __forceinline__ size_t abase(const Unit& u) const { return (size_t)u.pm * BM * K * 2; }
    __device__ __forceinline__ void aoffs(const Unit&, int, unsigned (&)[2][2]) const {}
    __device__ __forceinline__ void aoffs_lds(const Unit&, int, int, unsigned (&)[2][2]) const {}
    __device__ __forceinline__ void unit_begin(const Unit&, const Unit&, bool, int, int, int) const {}
};
constexpr int UT_TOK = 0, UT_ROWA = 1024, UT_ROWB = 2048, UT_BIAS = 3072, UT_BYTES = 4096;
template <bool GATHER_> struct MoeOrder {
    static constexpr bool GATHER = GATHER_; static constexpr int BPAD = 0;
    int G, c, NT, nRB, K; const char* W; size_t wstride; const PG8_LAS int* rbtab; const PG8_LAS int* cntl; const int* tok_list;
    PG8_LAS unsigned char* utab;
    const float* rowa; const int* rowb; const float* bias0; const float* bias1;
    __device__ __forceinline__ bool next(int i, Unit& u) const {
        const int L = i * G + c, per = 8 * NT, grp = L / per, rem = L % per, j = rem >> 3, rb = grp * 8 + (rem & 7);
        if (rb >= nRB) return false;
        const int pk = __builtin_amdgcn_readfirstlane(rbtab[rb]); u.e = pk >> 16; u.pm = rb; u.pn = j; u.r0 = (pk & 0xffff) * 256;
        const int left = __builtin_amdgcn_readfirstlane(cntl[u.e]) - u.r0; u.nv = left < 256 ? left : 256; return true;
    }
    __device__ __forceinline__ const char* bbase(const Unit& u) const { return W + (size_t)u.e * wstride + (size_t)u.pn * BM * K * 2; }
    __device__ __forceinline__ size_t abase(const Unit& u) const { return GATHER ? (size_t)0 : (size_t)u.pm * BM * K * 2; }
    __device__ __forceinline__ void aoffs(const Unit& u, int tid, unsigned (&o)[2][2]) const {
        if (GATHER) {
            asm volatile("" : "+v"(tid));
            int tok[2][2];
#pragma unroll
            for (int i = 0; i < 2; ++i) { int R, C; stage_rc(tid * 16 + i * 8192, R, C);
#pragma unroll
                for (int h = 0; h < 2; ++h) { const int rl = h * HALF + R, rc = rl < u.nv ? rl : u.nv - 1; tok[h][i] = tok_list[(size_t)u.e * NTOK + u.r0 + rc]; } }
#pragma unroll
            for (int i = 0; i < 2; ++i) { int R, C; stage_rc(tid * 16 + i * 8192, R, C);
#pragma unroll
                for (int h = 0; h < 2; ++h) o[h][i] = (unsigned)(tok[h][i] * K + C) * 2u; }
        }
    }
    __device__ __forceinline__ void aoffs_lds(const Unit& u, int wid, int ui, unsigned (&o)[2][2]) const {
        if (GATHER) {
            const int tid = wid * 64 + lane_now();
            const PG8_LAS int* tt = (const PG8_LAS int*)(utab + (ui & 1) * UT_BYTES + UT_TOK);
#pragma unroll
            for (int i = 0; i < 2; ++i) { int R, C; stage_rc(tid * 16 + i * 8192, R, C);
#pragma unroll
                for (int h = 0; h < 2; ++h) { const int rl = h * HALF + R; const int tok = rl < u.nv ? tt[rl] : 0; o[h][i] = (unsigned)(tok * K + C) * 2u; } }
        }
    }
    __device__ __forceinline__ void unit_begin(const Unit& cur, const Unit& nxt, bool has_next, int ui, int wid, int lane) const {
        PG8_LAS unsigned char* tb = utab + (ui & 1) * UT_BYTES;
        const size_t li = (size_t)cur.e * NTOK + cur.r0;
        (void)lane;
        const unsigned lo = (unsigned)lane_now() * 4u;
#define PG8_DMA4(gptr, ldsptr) __builtin_amdgcn_global_load_lds((const unsigned*)((const char*)(gptr) + lo), (PG8_LAS unsigned*)(ldsptr), 4, 0, 0)
        if (wid < 4) {
            PG8_DMA4(rowa + li + 64 * wid, tb + UT_ROWA + 256 * wid);
            if (GATHER && has_next) PG8_DMA4(tok_list + (size_t)nxt.e * NTOK + nxt.r0 + 64 * wid, tb + UT_TOK + 256 * wid);
        } else {
            const int q = wid - 4;
            if (GATHER) PG8_DMA4((q < 2 ? bias0 : bias1) + (size_t)cur.e * DEXP + cur.pn * HALF + 64 * (q & 1), tb + UT_BIAS + 256 * q);
            else { PG8_DMA4(bias0 + (size_t)cur.e * DM + cur.pn * BM + 64 * q, tb + UT_BIAS + 256 * q);
                PG8_DMA4(rowb + li + 64 * q, tb + UT_ROWB + 256 * q); }
        }
#undef PG8_DMA4
    }
};

struct XposeRows {
    PG8_LAS unsigned char* xw; int wa, rd;
    __device__ __forceinline__ void init(PG8_LAS unsigned char* xs, int wid, int fr, int fq) { const int lane = fq * 16 + fr; xw = xs + wid * 2048;
        wa = fr * 128 + (((2 * fq) ^ (fr & 7)) << 4); rd = (lane >> 3) * 128 + (((lane & 7) ^ (lane >> 3)) << 4); }
    __device__ __forceinline__ void run(const u32x4& a0, const u32x4& a1, u32x4& d0, u32x4& d1) const {
        *(PG8_LAS u32x4*)(xw + wa) = a0; *(PG8_LAS u32x4*)(xw + (wa ^ 16)) = a1;
        __builtin_amdgcn_wave_barrier();
        d0 = *(const PG8_LAS u32x4*)(xw + rd); d1 = *(const PG8_LAS u32x4*)(xw + rd + 1024);
        __builtin_amdgcn_wave_barrier(); }
};
struct EpiQKV {
    static constexpr bool PERM = true, PERM16 = true; static constexpr int NSTORE = 16;
    bf16_t* O; int ldc; PG8_LAS unsigned char* xs;
    __device__ __forceinline__ void operator()(const f32x4 (&acc)[2][2][4][2], const Unit& u, int, int wr, int wc, int fr, int fq) const {
        const int lane = fq * 16 + fr;
        XposeRows X; X.init(xs, wr * 4 + wc, fr, fq);
        bf16_t* const p0 = O + (size_t)(u.pm * BM + wr * 64 + (lane >> 3)) * ldc + u.pn * BM + wc * 64 + 8 * (lane & 7);
#pragma unroll
        for (int ai = 0; ai < 2; ++ai)
#pragma unroll
            for (int m = 0; m < 4; ++m) { bf16_t* rowp = p0 + (size_t)(ai * HALF + m * 16) * ldc;
                u32x4 own[2];
#pragma unroll
                for (int bj = 0; bj < 2; ++bj) { const f32x4 v0 = acc[ai][bj][m][0] * (1.0f / KREP_P1), v1 = acc[ai][bj][m][1] * (1.0f / KREP_P1);
                    own[bj].x = cvt_pk_bf16(v0[0], v0[1]); own[bj].y = cvt_pk_bf16(v0[2], v0[3]); own[bj].z = cvt_pk_bf16(v1[0], v1[1]); own[bj].w = cvt_pk_bf16(v1[2], v1[3]); }
                u32x4 d0, d1; X.run(own[0], own[1], d0, d1);
                *(u32x4*)rowp = d0; *(u32x4*)(rowp + (size_t)8 * ldc) = d1; }
    }
};
struct EpiWo {
    static constexpr bool PERM = true, PERM16 = true; static constexpr int NSTORE = 24;
    const bf16_t* XNp; const float* RMS; bf16_t* X1b; unsigned char* X1q; const float* GM;
    __device__ __forceinline__ void operator()(const f32x4 (&acc)[2][2][4][2], const Unit& u, int, int wr, int wc, int fr, int fq) const {
        const int row0 = u.pm * BM + wr * 64 + fr, col0 = u.pn * BM + wc * 64 + 16 * fq;
        f32x4 gm[2][2];
#pragma unroll
        for (int bj = 0; bj < 2; ++bj)
#pragma unroll
            for (int n = 0; n < 2; ++n) gm[bj][n] = *(const f32x4*)(GM + col0 + 8 * bj + 4 * n);
#pragma unroll
        for (int ai = 0; ai < 2; ++ai)
#pragma unroll
            for (int m = 0; m < 4; ++m) { const int row = row0 + ai * HALF + m * 16; const size_t off = (size_t)row * DM + col0; const float rms = RMS[row];
                int q8[4];
#pragma unroll
                for (int bj = 0; bj < 2; ++bj) { const size_t o2 = off + 8 * bj; const u32x4 xw = *(const u32x4*)(XNp + o2);
                    float v[8];
#pragma unroll
                    for (int q = 0; q < 4; ++q) { v[2 * q] = __builtin_bit_cast(float, xw[q] << 16) * rms + acc[ai][bj][m][q >> 1][(q & 1) * 2]; v[2 * q + 1] = __builtin_bit_cast(float, xw[q] & 0xffff0000u) * rms + acc[ai][bj][m][q >> 1][(q & 1) * 2 + 1]; }
                    u32x4 w; w.x = cvt_pk_bf16(v[0], v[1]); w.y = cvt_pk_bf16(v[2], v[3]); w.z = cvt_pk_bf16(v[4], v[5]); w.w = cvt_pk_bf16(v[6], v[7]); *(u32x4*)(X1b + o2) = w;
                    const f32x4 g0 = gm[bj][0], g1 = gm[bj][1];
                    int q0 = 0, q1 = 0; q0 = __builtin_amdgcn_cvt_pk_fp8_f32(v[0] * g0[0], v[1] * g0[1], q0, false); q0 = __builtin_amdgcn_cvt_pk_fp8_f32(v[2] * g0[2], v[3] * g0[3], q0, true);
                    q1 = __builtin_amdgcn_cvt_pk_fp8_f32(v[4] * g1[0], v[5] * g1[1], q1, false); q1 = __builtin_amdgcn_cvt_pk_fp8_f32(v[6] * g1[2], v[7] * g1[3], q1, true);
                    q8[2 * bj] = q0; q8[2 * bj + 1] = q1; }
                u32x4 w8; w8.x = (unsigned)q8[0]; w8.y = (unsigned)q8[1]; w8.z = (unsigned)q8[2]; w8.w = (unsigned)q8[3]; *(u32x4*)(X1q + off) = w8; }
    }
};
struct EpiGU {
    static constexpr bool PERM = true, PERM16 = false; static constexpr int NSTORE = 0;
    unsigned char* ACT; const PG8_LAS unsigned char* utab;
    __device__ __forceinline__ void operator()(const f32x4 (&acc)[2][2][4][2], const Unit& u, int ui, int wr, int wc, int fr, int fq) const {
        const PG8_LAS unsigned char* tb = utab + (ui & 1) * UT_BYTES;
        const PG8_LAS float* rsl = (const PG8_LAS float*)(tb + UT_ROWA); const PG8_LAS float* bl = (const PG8_LAS float*)(tb + UT_BIAS);
        const int rl0 = wr * 64 + fr, cl = wc * 32 + 8 * fq, colt = u.pn * HALF + cl;
        f32x4 bgv[2], buv[2];
#pragma unroll
        for (int n = 0; n < 2; ++n) { bgv[n] = *(const PG8_LAS f32x4*)(bl + cl + 4 * n); buv[n] = *(const PG8_LAS f32x4*)(bl + HALF + cl + 4 * n); }
#pragma unroll
        for (int ai = 0; ai < 2; ++ai)
#pragma unroll
            for (int m = 0; m < 4; ++m) { const int rl = rl0 + ai * HALF + m * 16; const float rs = rsl[rl] * (1.0f / 512.0f);
                float a[8];
#pragma unroll
                for (int n = 0; n < 2; ++n)
#pragma unroll
                    for (int j = 0; j < 4; j += 2) {
                        typedef float f2 __attribute__((ext_vector_type(2)));
                        const f2 rs2 = {rs, rs};
                        f2 g = (f2){acc[ai][0][m][n][j], acc[ai][0][m][n][j + 1]} * rs2 + (f2){bgv[n][j], bgv[n][j + 1]};
                        f2 l = (f2){acc[ai][1][m][n][j], acc[ai][1][m][n][j + 1]} * rs2 + (f2){buv[n][j], buv[n][j + 1]};
                        g.x = fminf(g.x, 7.0f); g.y = fminf(g.y, 7.0f); l.x = fminf(fmaxf(l.x, -7.0f), 7.0f); l.y = fminf(fmaxf(l.y, -7.0f), 7.0f);
                        const f2 t = g * (f2){-1.702f * LOG2E, -1.702f * LOG2E};
                        f2 e; e.x = __builtin_amdgcn_exp2f(t.x); e.y = __builtin_amdgcn_exp2f(t.y);
                        const f2 d = e + (f2){1.0f, 1.0f};
                        f2 sg; sg.x = __builtin_amdgcn_rcpf(d.x); sg.y = __builtin_amdgcn_rcpf(d.y);
                        const f2 r = (g * sg) * (l + (f2){1.0f, 1.0f});
                        a[n * 4 + j] = r.x; a[n * 4 + j + 1] = r.y; }
                int q0 = 0, q1 = 0; q0 = __builtin_amdgcn_cvt_pk_fp8_f32(a[0], a[1], q0, false); q0 = __builtin_amdgcn_cvt_pk_fp8_f32(a[2], a[3], q0, true);
                q1 = __builtin_amdgcn_cvt_pk_fp8_f32(a[4], a[5], q1, false); q1 = __builtin_amdgcn_cvt_pk_fp8_f32(a[6], a[7], q1, true);
                u32x2 w; w.x = (unsigned)q0; w.y = (unsigned)q1;
                *(u32x2*)(ACT + (size_t)(u.pm * BM + rl) * DEXP + colt) = w; }
    }
};
struct EpiDown {
    static constexpr bool PERM = true, PERM16 = true; static constexpr int NSTORE = 0;
    unsigned char* Y; const PG8_LAS unsigned char* utab;
    __device__ __forceinline__ void operator()(const f32x4 (&acc)[2][2][4][2], const Unit& u, int ui, int wr, int wc, int fr, int fq) const {
        const PG8_LAS unsigned char* tb = utab + (ui & 1) * UT_BYTES;
        const PG8_LAS float* gl = (const PG8_LAS float*)(tb + UT_ROWA); const PG8_LAS int* dl = (const PG8_LAS int*)(tb + UT_ROWB); const PG8_LAS float* bl = (const PG8_LAS float*)(tb + UT_BIAS);
        const int rl0 = wr * 64 + fr, cl = wc * 64 + 16 * fq, colt = u.pn * BM + cl;
        f32x4 bv[2][2];
#pragma unroll
        for (int bj = 0; bj < 2; ++bj)
#pragma unroll
            for (int n = 0; n < 2; ++n) bv[bj][n] = *(const PG8_LAS f32x4*)(bl + cl + 8 * bj + 4 * n);
#pragma unroll
        for (int ai = 0; ai < 2; ++ai)
#pragma unroll
            for (int m = 0; m < 4; ++m) { const int rl = rl0 + ai * HALF + m * 16;
                if (rl < u.nv) { const float gt = gl[rl] * 8.0f; const int dst = dl[rl];
                    __attribute__((address_space(1))) unsigned char* rowp = (__attribute__((address_space(1))) unsigned char*)Y + (size_t)dst * DM + colt;
                    int q8[4];
#pragma unroll
                    for (int bj = 0; bj < 2; ++bj) { const f32x4 v0 = (acc[ai][bj][m][0] * (1.0f / 512.0f) + bv[bj][0]) * gt, v1 = (acc[ai][bj][m][1] * (1.0f / 512.0f) + bv[bj][1]) * gt;
                        int q0 = 0, q1 = 0; q0 = __builtin_amdgcn_cvt_pk_fp8_f32(v0[0], v0[1], q0, false); q0 = __builtin_amdgcn_cvt_pk_fp8_f32(v0[2], v0[3], q0, true);
                        q1 = __builtin_amdgcn_cvt_pk_fp8_f32(v1[0], v1[1], q1, false); q1 = __builtin_amdgcn_cvt_pk_fp8_f32(v1[2], v1[3], q1, true);
                        q8[2 * bj] = q0; q8[2 * bj + 1] = q1; }
                    u32x4 w; w.x = (unsigned)q8[0]; w.y = (unsigned)q8[1]; w.z = (unsigned)q8[2]; w.w = (unsigned)q8[3];
                    *(__attribute__((address_space(1))) u32x4*)rowp = w; } }
    }
};

typedef int v8i __attribute__((ext_vector_type(8)));
typedef int v4i __attribute__((ext_vector_type(4)));
template <class Epi, class Sched, bool FP8 = false, int KR = 1, int EREP = 1, bool ALIGN = true>
__device__ __forceinline__ void gemm_phase(PG8_LAS unsigned char* lds, const void* Abase, const int K, const Sched& S, const Epi& E, const int wid_in) {
    unsigned z_ = 0u; asm volatile("" : "+s"(z_));
    int tid = wid_in * 64 + (int)__builtin_amdgcn_mbcnt_hi(~0u, __builtin_amdgcn_mbcnt_lo(~0u, z_)); asm volatile("" : "+v"(tid));
    const int wid = wid_in, lane = tid & 63, wr = wid >> 2, wc = wid & 3, fr = lane & 15, fq = lane >> 4;
    const int nt = K / BK;
    unsigned voffA[2], voffB[2];
#pragma unroll
    for (int i = 0; i < 2; ++i) { int R, C; stage_rc(tid * 16 + i * 8192, R, C); const int Rp = Epi::PERM ? ((R & ~31) + perm32(R & 31)) : R;
        const int Rb = Epi::PERM16 ? (2 * (Rp & ~7) + (Rp & 7)) : Rp;
        voffA[i] = (unsigned)(R * K + C) * 2u; voffB[i] = (unsigned)(Rb * (K + Sched::BPAD) + C) * 2u; }
    const size_t kstep = (size_t)(BK * 2);
    const size_t hstep = (size_t)HALF * K * 2;
    const size_t bhstep = Epi::PERM16 ? (size_t)8 * (K + Sched::BPAD) * 2 : (size_t)HALF * (K + Sched::BPAD) * 2;
    const unsigned ldsw = (unsigned)wid * 1024u;
    const int aoff0 = lds_chunk(wr * 64 + fr, fq), boff0 = lds_chunk(wc * 32 + fr, fq) + 4 * HTB;
#define PG8_KH1(off0, var) unsigned var = (unsigned)(off0) ^ 64u; asm volatile("" : "+v"(var))
#define PG8_SA(b, h) (((b) * 2 + (h)) * HTB)
#define PG8_SB(b, h) ((4 + (b) * 2 + (h)) * HTB)
#define PG8_SBR(b, h) (((b) * 2 + (h)) * HTB)
#define PG8_STAGE(bufoff, gbase, voff) do { _Pragma("unroll") for (int _i = 0; _i < 2; ++_i) { unsigned _o = (voff)[_i]; asm volatile("" : "+v"(_o));     \
        __builtin_amdgcn_global_load_lds((const unsigned*)((const char*)(gbase) + _o), (PG8_LAS unsigned*)(lds + (bufoff) + ldsw + _i * 8192), 16, 0, 0); } } while (0)
#define PG8_LD8(a0, a1) __builtin_shufflevector(*(const PG8_LAS v4i*)(a0), *(const PG8_LAS v4i*)(a1), 0, 1, 2, 3, 4, 5, 6, 7)
#define PG8_LDA(dst, b, h) do { PG8_KH1(aoff0, aoff1_); if constexpr (FP8) { _Pragma("unroll") for (int m = 0; m < 4; ++m) dst##8[m] = PG8_LD8(lds + PG8_SA(b, h) + aoff0 + m * 2048, lds + PG8_SA(b, h) + aoff1_ + m * 2048); } \
        else { _Pragma("unroll") for (int m = 0; m < 4; ++m) { dst[m][0] = *(const PG8_LAS bf16x8*)(lds + PG8_SA(b, h) + aoff0 + m * 2048); dst[m][1] = *(const PG8_LAS bf16x8*)(lds + PG8_SA(b, h) + aoff1_ + m * 2048); } } } while (0)
#define PG8_LDB(dst, b, h) do { PG8_KH1(boff0, boff1_); if constexpr (FP8) { _Pragma("unroll") for (int n = 0; n < 2; ++n) dst##8[n] = PG8_LD8(lds + PG8_SBR(b, h) + boff0 + n * 2048, lds + PG8_SBR(b, h) + boff1_ + n * 2048); } \
        else { _Pragma("unroll") for (int n = 0; n < 2; ++n) { dst[n][0] = *(const PG8_LAS bf16x8*)(lds + PG8_SBR(b, h) + boff0 + n * 2048); dst[n][1] = *(const PG8_LAS bf16x8*)(lds + PG8_SBR(b, h) + boff1_ + n * 2048); } } } while (0)
#define PG8_MMA(ai, bj, At, Bt) do { __builtin_amdgcn_s_setprio(1); \
        if constexpr (FP8) { _Pragma("unroll") for (int m = 0; m < 4; ++m) _Pragma("unroll") for (int n = 0; n < 2; ++n) \
            acc[ai][bj][m][n] = __builtin_amdgcn_mfma_scale_f32_16x16x128_f8f6f4(Bt##8[n], At##8[m], acc[ai][bj][m][n], 0, 0, 0, 0x7f7f7f7f, 0, 0x7f7f7f7f); } \
        else { _Pragma("unroll") for (int m = 0; m < 4; ++m) _Pragma("unroll") for (int n = 0; n < 2; ++n) _Pragma("unroll") for (int k = 0; k < 2; ++k) \
            acc[ai][bj][m][n] = __builtin_amdgcn_mfma_f32_16x16x32_bf16(Bt[n][k], At[m][k], acc[ai][bj][m][n], 0, 0, 0); } \
        __builtin_amdgcn_s_setprio(0); } while (0)
#define PG8_WAIT_V(n) asm volatile("s_waitcnt vmcnt(" #n ")" ::: "memory")
#define PG8_WAIT_L(n) asm volatile("s_waitcnt lgkmcnt(" #n ")" ::: "memory")
#define PG8_WAIT_VF(t_) asm volatile("s_cmp_lg_u32 %0, 0\n\ts_cbranch_scc1 1f\n\ts_waitcnt vmcnt(%1)\n\ts_branch 2f\n1:\n\ts_waitcnt vmcnt(8)\n2:" :: "s"(t_), "n"(8 + Epi::NSTORE) : "memory", "scc")
#define PG8_BAR __builtin_amdgcn_s_barrier()
#define PG8_SCHED __builtin_amdgcn_sched_barrier(0)
    Unit cur, nxt; int ui = 0;
    if (!S.next(0, cur)) return;
    f32x4 acc[2][2][4][2];
#pragma unroll
    for (int a = 0; a < 2; ++a)
#pragma unroll
        for (int b = 0; b < 2; ++b)
#pragma unroll
            for (int m = 0; m < 4; ++m)
#pragma unroll
                for (int n = 0; n < 2; ++n) acc[a][b][m][n] = (f32x4){0.f, 0.f, 0.f, 0.f};
    bf16x8 At[4][2], B0[2][2], B1[2][2];
    v8i At8[4], B08[2], B18[2];
    unsigned ca[2][2];
    S.aoffs(cur, tid, ca);
    const char* const Ab = (const char*)Abase;
    const char* cA = Ab + S.abase(cur);
    const char* cB = S.bbase(cur);
#define PG8_STAGE_A(bufoff, kb, h, nx) do { if constexpr (Sched::GATHER) { PG8_STAGE(bufoff, Ab + (kb), ca[h]); } \
        else PG8_STAGE(bufoff, ((nx) ? nA : cA) + (kb) + (h) * hstep, voffA); } while (0)
    const char* nA = cA;
    PG8_STAGE(PG8_SB(0, 0), cB, voffB); PG8_STAGE(PG8_SB(0, 1), cB + bhstep, voffB); PG8_STAGE_A(PG8_SA(0, 0), 0, 0, false); PG8_STAGE_A(PG8_SA(0, 1), 0, 1, false);
    if (wr == 1) PG8_BAR;
    PG8_WAIT_V(2); PG8_BAR;
    PG8_STAGE(PG8_SB(1, 0), cB + kstep, voffB); PG8_STAGE_A(PG8_SA(1, 0), kstep, 0, false); PG8_STAGE(PG8_SB(1, 1), cB + bhstep + kstep, voffB);
    PG8_STAGE_A(PG8_SA(1, 1), kstep, 1, false); PG8_WAIT_V(0);
    PG8_BAR;
    for (;;) {
        const bool has_next = S.next(ui + 1, nxt);
        S.unit_begin(cur, nxt, has_next, ui, wid, lane);
        nA = has_next ? Ab + S.abase(nxt) : cA;
        const char* nB = has_next ? S.bbase(nxt) : cB;
#pragma unroll 1
        for (int t = 0; t < nt * KR; t += 2) {
            const bool last = (t == nt * KR - 2);
            const int tw2 = (KR > 1) ? ((t + 2) & (nt - 1)) : (t + 2);
            const size_t k1 = (size_t)((KR > 1) ? ((t + 1) & (nt - 1)) : (t + 1)) * kstep; const size_t k2 = last ? (size_t)0 : (size_t)tw2 * kstep, k3 = k2 + kstep;
            const char* b2 = last ? nB : cB + (size_t)tw2 * kstep; const char* b3 = b2 + kstep;
            PG8_LDB(B0, 0, 0); PG8_LDB(B1, 0, 1); PG8_SCHED; PG8_LDA(At, 0, 0); if (t != 0) PG8_STAGE_A(PG8_SA(1, 1), k1, 1, false);
            PG8_WAIT_VF(t); PG8_WAIT_L(0); PG8_BAR; PG8_MMA(0, 0, At, B0); PG8_MMA(0, 1, At, B1);
            if (Sched::GATHER && last && has_next) { asm volatile("" ::: "memory"); S.aoffs_lds(nxt, wid, ui, ca); }
            PG8_BAR; PG8_SCHED;
            PG8_LDA(At, 0, 1); PG8_STAGE(PG8_SB(0, 0), b2, voffB); PG8_STAGE(PG8_SB(0, 1), b2 + bhstep, voffB); PG8_STAGE_A(PG8_SA(0, 0), k2, 0, last);
            PG8_WAIT_VF(t); PG8_WAIT_L(0); PG8_BAR; PG8_MMA(1, 0, At, B0); PG8_MMA(1, 1, At, B1); PG8_BAR; PG8_SCHED;
            PG8_LDB(B0, 1, 0); PG8_LDB(B1, 1, 1); PG8_SCHED; PG8_LDA(At, 1, 0); PG8_STAGE_A(PG8_SA(0, 1), k2, 1, last);
            PG8_WAIT_VF(t); PG8_WAIT_L(0); PG8_BAR; PG8_MMA(0, 0, At, B0); PG8_MMA(0, 1, At, B1); PG8_BAR; PG8_SCHED;
            PG8_LDA(At, 1, 1); PG8_STAGE(PG8_SB(1, 0), b3, voffB); PG8_STAGE(PG8_SB(1, 1), b3 + bhstep, voffB); PG8_STAGE_A(PG8_SA(1, 0), k3, 0, last);
            PG8_WAIT_V(8); PG8_WAIT_L(0); PG8_BAR; PG8_MMA(1, 0, At, B0); PG8_MMA(1, 1, At, B1); PG8_BAR; PG8_SCHED;
        }
        PG8_STAGE_A(PG8_SA(1, 1), kstep, 1, true);
        if (ALIGN && wr == 0) PG8_BAR;
        { const int l2 = lane_now();
          E(acc, cur, ui, wr, wc, l2 & 15, l2 >> 4);
          if constexpr (EREP > 1) { asm volatile("" ::: "memory"); const int l3 = lane_now(); E(acc, cur, ui, wr, wc, l3 & 15, l3 >> 4); } }
        if (!has_next) break;
#pragma unroll
        for (int a = 0; a < 2; ++a)
#pragma unroll
            for (int b = 0; b < 2; ++b)
#pragma unroll
                for (int m = 0; m < 4; ++m)
#pragma unroll
                    for (int n = 0; n < 2; ++n) acc[a][b][m][n] = (f32x4){0.f, 0.f, 0.f, 0.f};
        cur = nxt; cB = nB; cA = nA; ++ui;
        if (ALIGN && wr == 1) PG8_BAR;
    }
    if (!ALIGN && wr == 0) PG8_BAR;
    PG8_WAIT_V(0);
    PG8_BAR;
#undef PG8_SA
#undef PG8_SB
#undef PG8_SBR
#undef PG8_STAGE
#undef PG8_STAGE_A
#undef PG8_KH1
#undef PG8_LDA
#undef PG8_LDB
#undef PG8_MMA
#undef PG8_WAIT_V
#undef PG8_WAIT_L
#undef PG8_WAIT_VF
#undef PG8_BAR
#undef PG8_SCHED
}
}

typedef unsigned short bf16;
typedef unsigned v4u __attribute__((ext_vector_type(4)));
typedef unsigned v2u __attribute__((ext_vector_type(2)));
typedef float f32x4 __attribute__((ext_vector_type(4)));
typedef float f32x16 __attribute__((ext_vector_type(16)));
typedef short bf16x8 __attribute__((ext_vector_type(8)));
typedef short s16x4 __attribute__((ext_vector_type(4)));
typedef GAS unsigned gu32;
#define RLX_AGENT __ATOMIC_RELAXED, __HIP_MEMORY_SCOPE_AGENT
#define LDS_WAIT() asm volatile("s_waitcnt lgkmcnt(0)" ::: "memory")
#define VM_WAIT() asm volatile("s_waitcnt vmcnt(0)" ::: "memory")
__device__ __forceinline__ unsigned f2bf(float f) { unsigned u = __builtin_bit_cast(unsigned, f); return (u + 0x7fffu + ((u >> 16) & 1u)) >> 16; }
__device__ __forceinline__ unsigned pk2(float lo, float hi) { return f2bf(lo) | (f2bf(hi) << 16); }
__device__ __forceinline__ float bflo(unsigned u) { return __builtin_bit_cast(float, u << 16); }
__device__ __forceinline__ float bfhi(unsigned u) { return __builtin_bit_cast(float, u & 0xffff0000u); }

#define XB_TMO      128
#define XB_XCNT(j)  (256  + 64 * (j))
#define XB_XSUB(j)  (1280 + 64 * (j))
#define XB_XGEN(j)  (2304 + 64 * (j))
#define XB_TOP      3328
#define XB_TOPGEN   3392
#define XCD_BAR_WORDS 3456
#define XB_SPIN_CAP (1u << 18)
__device__ __forceinline__ unsigned xb_ld(unsigned* p)              { return __hip_atomic_load(p, __ATOMIC_RELAXED, __HIP_MEMORY_SCOPE_AGENT); }
__device__ __forceinline__ unsigned xb_add(unsigned* p, unsigned v) { return __hip_atomic_fetch_add(p, v, __ATOMIC_RELAXED, __HIP_MEMORY_SCOPE_AGENT); }
__device__ __forceinline__ unsigned xb_xcc_id() { return (unsigned)__builtin_amdgcn_s_getreg((3 << 11) | 20) & 0xFu; }
#define XB_SPIN(cond, bar) do { unsigned _sp = 0; while (cond) { __builtin_amdgcn_s_sleep(1); \
    if ((++_sp & 255u) == 0u) { if (xb_ld(&(bar)[XB_TMO])) break; if (_sp > XB_SPIN_CAP) { atomicAdd(&(bar)[XB_TMO], 1u); break; } } } } while (0)
struct XcdBarrier { unsigned* bar; unsigned x; volatile LAS unsigned* st; };
__device__ __forceinline__ XcdBarrier xcd_barrier_post(unsigned* bar, volatile LAS unsigned* st) {
    XcdBarrier b; b.bar = bar; b.x = xb_xcc_id(); b.st = st;
    if (threadIdx.x == 0) (void)xb_add(&bar[XB_XCNT(b.x)], 1u);
    return b;
}
__device__ __forceinline__ void xcd_barrier_complete(unsigned* bar, unsigned x, unsigned& nloc, unsigned& nx) {
    const unsigned G = gridDim.x * gridDim.y * gridDim.z;
    unsigned sum, cnt, mine, sp = 0u;
    for (;;) {
        sum = 0u; cnt = 0u; mine = 0u;
#pragma unroll
        for (unsigned j = 0; j < 16; ++j) { const unsigned c = xb_ld(&bar[XB_XCNT(j)]); sum += c; cnt += (c > 0u) ? 1u : 0u; mine = (j == x) ? c : mine; }
        if (sum == G) break;
        __builtin_amdgcn_s_sleep(1);
        if ((++sp & 255u) == 0u) { if (xb_ld(&bar[XB_TMO])) break; if (sp > XB_SPIN_CAP) { atomicAdd(&bar[XB_TMO], 1u); break; } }
    }
    nloc = mine > 0u ? mine : 1u; nx = cnt > 0u ? cnt : 1u;
}
__device__ __forceinline__ void xcd_barrier(const XcdBarrier& b, const int wid) {
    asm volatile("s_waitcnt vmcnt(0)" ::: "memory");
    __syncthreads();
    unsigned zb_ = 0u; asm volatile("" : "+s"(zb_));
    if (wid == 0 && __builtin_amdgcn_mbcnt_hi(~0u, __builtin_amdgcn_mbcnt_lo(~0u, zb_)) == 0u) {
        unsigned* bar = b.bar;
        __builtin_amdgcn_s_waitcnt(0);
        unsigned nloc = b.st[0], nx = b.st[1];
        if (nloc == 0u) { xcd_barrier_complete(bar, b.x, nloc, nx); b.st[0] = nloc; b.st[1] = nx; }
        const unsigned old = xb_add(&bar[XB_XSUB(b.x)], 1u);
        const unsigned gen = old / nloc;
        if (old + 1u == (gen + 1u) * nloc) {
            __builtin_amdgcn_fence(__ATOMIC_RELEASE, "agent");
            asm volatile("s_waitcnt vmcnt(0)" ::: "memory");
            const unsigned og = xb_add(&bar[XB_TOP], 1u);
            const unsigned tg = og / nx;
            if (og + 1u == (tg + 1u) * nx) xb_add(&bar[XB_TOPGEN], 1u);
            else XB_SPIN(xb_ld(&bar[XB_TOPGEN]) == tg, bar);
            __builtin_amdgcn_fence(__ATOMIC_ACQUIRE, "agent");
            xb_add(&bar[XB_XGEN(b.x)], 1u);
            asm volatile("s_waitcnt vmcnt(0)" ::: "memory");
        } else {
            XB_SPIN(xb_ld(&bar[XB_XGEN(b.x)]) == gen, bar);
            __builtin_amdgcn_fence(__ATOMIC_ACQUIRE, "agent");
            asm volatile("s_waitcnt vmcnt(0)" ::: "memory");
        }
    }
    __syncthreads();
}

constexpr size_t MiB = 1u << 20;
constexpr size_t WS_CTL = 0, CTL_ZERO_BYTES = 1 * MiB;
constexpr int WPITCH = DM + 64;
constexpr size_t WS_WQKV = 972 * MiB;
constexpr size_t WS_WO = 980 * MiB;
constexpr size_t WS_WD = 9 * MiB;
constexpr size_t WS_TOK = 41 * MiB;
constexpr size_t WS_GATE = 49 * MiB;
constexpr size_t WS_RS = 57 * MiB;
constexpr size_t WS_DST = 65 * MiB;
constexpr size_t WS_X1B = 73 * MiB;
constexpr size_t WS_X1Q = 201 * MiB;
constexpr size_t WS_BIG = 265 * MiB;
constexpr size_t WS_XN = WS_BIG, WS_QKV = WS_BIG + 128 * MiB, WS_ACT = WS_BIG;
constexpr size_t WS_Y1 = WS_BIG + 264 * MiB;
constexpr size_t WS_WGU = WS_BIG + 512 * MiB;
constexpr size_t WS_O = WS_WGU + 64 * MiB;
constexpr size_t WS_RMS1 = WS_O + 128 * MiB;
constexpr size_t WS_END = 984 * MiB;
static_assert(WS_QKV + (size_t)NTOK * NQKV * 2 <= WS_WGU && WS_ACT + (size_t)NSLOT * DEXP <= WS_Y1 && WS_Y1 + (size_t)NTOK * 2 * DM * 2 <= WS_END && WS_END <= 1024 * MiB, "d_ws map");
constexpr int CW_CNT = 64;
constexpr int CW_BAR = 4096;

constexpr int RING_BYTES = 131072;
constexpr int MISC_OFF = RING_BYTES + 320;
constexpr int HIST_OFF = RING_BYTES + 512, BASE_OFF = RING_BYTES + 640, CNTL_OFF = RING_BYTES + 768, FIRST_OFF = RING_BYTES + 896, RBTAB_OFF = RING_BYTES + 1152;
constexpr int UTAB_OFF = RING_BYTES + 6144;
constexpr int XPOSE_OFF = 147456;
constexpr int LDS_BYTES = 163840;
static_assert(RBTAB_OFF + MAXRB * 4 <= UTAB_OFF && UTAB_OFF + 2 * 4096 <= XPOSE_OFF && XPOSE_OFF + 8 * 2048 <= LDS_BYTES, "LDS map");

struct Args { const float* in[17]; float* out; unsigned char* ws; };

__device__ __forceinline__ float wave_sum(float v) {
#pragma unroll
    for (int o = 1; o < 64; o <<= 1) v += __shfl_xor(v, o);
    return v;
}
__device__ __forceinline__ int crow(int r, int hi) { return (r & 3) + 8 * (r >> 2) + 4 * hi; }

template <bool SIG = false>
__device__ __forceinline__ void p0_item(const float* W, int N, bf16* WTrow  , int K, const float* gk, float sn, int k0, int n0, int lane) {
    const GAS f32x4* src = (const GAS f32x4*)(W + (size_t)k0 * N + n0) + lane;
    const int n4 = N >> 2;
#pragma unroll 2
    for (int g = 0; g < 8; ++g) {
        f32x4 v[8];
#pragma unroll
        for (int i = 0; i < 8; ++i) v[i] = src[(size_t)(8 * g + i) * n4];
#pragma unroll
        for (int i = 0; i < 8; ++i) { const float sc = gk ? gk[k0 + 8 * g + i] * sn : sn; v[i] = v[i] * sc; }
#pragma unroll
        for (int j = 0; j < 4; ++j) { v4u o; o.x = pk2(v[0][j], v[1][j]); o.y = pk2(v[2][j], v[3][j]); o.z = pk2(v[4][j], v[5][j]); o.w = pk2(v[6][j], v[7][j]);
            if (SIG) { v2u lo; lo.x = o.x; lo.y = o.y; v2u hh; hh.x = o.z; hh.y = o.w;
                *(GAS v2u*)(WTrow + (size_t)j * K + k0 + 4 * g) = lo; *(GAS v2u*)(WTrow + (size_t)j * K + k0 + 32 + 4 * g) = hh; }
            else *(GAS v4u*)(WTrow + (size_t)j * K + k0 + 8 * g) = o; }
    }
}
__device__ __forceinline__ void p0_item8(const float* W, int N, unsigned char* WTrow  , int K, const float* gk, float sn, int k0, int n0, int lane) {
    const GAS f32x4* src = (const GAS f32x4*)(W + (size_t)k0 * N + n0) + lane;
    const int n4 = N >> 2;
#pragma unroll 1
    for (int g = 0; g < 4; ++g) {
        f32x4 v[16];
#pragma unroll
        for (int i = 0; i < 16; ++i) v[i] = src[(size_t)(16 * g + i) * n4];
#pragma unroll
        for (int i = 0; i < 16; ++i) { const float sc = gk ? gk[k0 + 16 * g + i] * sn : sn; v[i] = v[i] * sc; }
#pragma unroll
        for (int j = 0; j < 4; ++j) { v4u o;
#pragma unroll
            for (int q = 0; q < 4; ++q) { int w = 0; w = __builtin_amdgcn_cvt_pk_fp8_f32(v[4 * q][j], v[4 * q + 1][j], w, false); w = __builtin_amdgcn_cvt_pk_fp8_f32(v[4 * q + 2][j], v[4 * q + 3][j], w, true); o[q] = (unsigned)w; }
            *(GAS v4u*)(WTrow + (size_t)j * K + k0 + 16 * g) = o; }
    }
}
__device__ __forceinline__ void p0_tile8(const float* W, int N, unsigned char* WT0  , int K, const float* gk, float sn, int k0, int n0, LAS unsigned char* scr, int lane) {
    lane = pg8::lane_now();
    const int ks = lane >> 4, n4 = lane & 15;
    const GAS f32x4* src = (const GAS f32x4*)(W + (size_t)(k0 + 4 * ks) * N + n0) + n4;
    const int n4s = N >> 2;
#pragma unroll 1
    for (int q0 = 0; q0 < 8; q0 += 4) {
        f32x4 v[4][4];
#pragma unroll
        for (int qq = 0; qq < 4; ++qq)
#pragma unroll
            for (int i = 0; i < 4; ++i) v[qq][i] = src[(size_t)(16 * (q0 + qq) + i) * n4s];
#pragma unroll
        for (int qq = 0; qq < 4; ++qq) { const int q = q0 + qq;
#pragma unroll
            for (int i = 0; i < 4; ++i) { const float sc = gk ? gk[k0 + 16 * q + 4 * ks + i] * sn : sn; v[qq][i] = v[qq][i] * sc; }
#pragma unroll
            for (int j = 0; j < 4; ++j) { int w = 0; w = __builtin_amdgcn_cvt_pk_fp8_f32(v[qq][0][j], v[qq][1][j], w, false); w = __builtin_amdgcn_cvt_pk_fp8_f32(v[qq][2][j], v[qq][3][j], w, true);
                const int n = 4 * n4 + j; *(LAS int*)(scr + n * 128 + ((q ^ ((n >> 2) & 7)) << 4) + 4 * ks) = w; } }
    }
#pragma unroll
    for (int i = 0; i < 8; ++i) { const int n = 8 * i + (lane >> 3), c = lane & 7;
        const v4u o = *(const LAS v4u*)(scr + n * 128 + ((c ^ ((n >> 2) & 7)) << 4));
        *(GAS v4u*)(WT0 + (size_t)n * K + k0 + 16 * c) = o; }
}
__device__ __forceinline__ void p0_load2(const float* x, int m, int lane, f32x4 (&v)[2][4]) {
    const GAS f32x4* xr = (const GAS f32x4*)(x + (size_t)m * DM) + lane;
#pragma unroll
    for (int q = 0; q < 2; ++q)
#pragma unroll
        for (int j = 0; j < 4; ++j) v[q][j] = xr[q * 256 + 64 * j];
}
__device__ __forceinline__ void p0_proc2(const f32x4 (&v)[2][4], bf16* XN, float* RMS1, int m, int lane) {
    float s2[2] = {0.f, 0.f};
#pragma unroll
    for (int q = 0; q < 2; ++q) {
#pragma unroll
        for (int j = 0; j < 4; ++j) s2[q] += (v[q][j].x * v[q][j].x + v[q][j].y * v[q][j].y) + (v[q][j].z * v[q][j].z + v[q][j].w * v[q][j].w);
        const float ms = wave_sum(s2[q]) * (1.0f / DM) + RMS_EPS, rstd = 1.0f / sqrtf(ms);
        if (lane == 0) RMS1[m + q] = sqrtf(ms);
        GAS unsigned long long* o8 = (GAS unsigned long long*)(XN + (size_t)(m + q) * DM) + lane;
#pragma unroll
        for (int j = 0; j < 4; ++j) o8[64 * j] = (unsigned long long)pk2(v[q][j].x * rstd, v[q][j].y * rstd) | ((unsigned long long)pk2(v[q][j].z * rstd, v[q][j].w * rstd) << 32);
    }
}
__device__ __forceinline__ void p0_rows(const float* x, bf16* XN, float* RMS1, int m0, int m1, int lane) {
    f32x4 va[2][4], vb[2][4];
    p0_load2(x, m0, lane, va);
#pragma unroll 1
    for (int m = m0; m < m1; m += 4) {
        const bool hb = m + 2 < m1;
        if (hb) p0_load2(x, m + 2, lane, vb);
        p0_proc2(va, XN, RMS1, m, lane);
        if (hb) { if (m + 4 < m1) p0_load2(x, m + 4, lane, va);
            p0_proc2(vb, XN, RMS1, m + 2, lane); }
    }
}

template <int B> __device__ __forceinline__ bf16x8 pack8(const f32x16& p) {
    v4u w; w.x = pg8::cvt_pk_bf16(p[B + 0], p[B + 1]); w.y = pg8::cvt_pk_bf16(p[B + 2], p[B + 3]); w.z = pg8::cvt_pk_bf16(p[B + 4], p[B + 5]); w.w = pg8::cvt_pk_bf16(p[B + 6], p[B + 7]);
    return __builtin_bit_cast(bf16x8, w);
}
typedef short v4i16_t __attribute__((ext_vector_type(4)));
__device__ __forceinline__ s16x4 vtr(const LAS unsigned char* p) { return __builtin_bit_cast(s16x4, __builtin_amdgcn_ds_read_tr16_b64_v4i16((LAS v4i16_t*)p)); }

struct KVt { v4u k[4]; v4u v[4]; };
constexpr int KIMG = 32 * 144, VIMG = 4096, KVIMG = KIMG + VIMG;
__device__ __forceinline__ void kv_put(LAS unsigned char* kst, LAS unsigned char* vst, const KVt& t, int lane) {
#pragma unroll
    for (int i = 0; i < 4; ++i) { *(LAS v4u*)(kst + (8 * i + (lane >> 3)) * 144 + (lane & 7) * 16) = t.k[i];
        *(LAS v4u*)(vst + ((lane & 7) >> 2) * 2048 + (8 * i + (lane >> 3)) * 64 + (lane & 3) * 16) = t.v[i]; }
}
__device__ __forceinline__ f32x16 qk_mma(const LAS unsigned char* kst, const bf16x8 (&qf)[4], int lane) {
    const LAS unsigned char* kp = kst + (lane & 31) * 144 + (lane >> 5) * 16;
    bf16x8 kf[4];
#pragma unroll
    for (int d0 = 0; d0 < 4; ++d0) kf[d0] = *(const LAS bf16x8*)(kp + d0 * 32);
    f32x16 p = {};
#pragma unroll
    for (int d0 = 0; d0 < 4; ++d0) p = __builtin_amdgcn_mfma_f32_32x32x16_bf16(kf[d0], qf[d0], p, 0, 0, 0);
    return p;
}
__device__ __forceinline__ void v_frags(bf16x8 (&vf)[2][2], const LAS unsigned char* vst, int lane) {
    const int hi = lane >> 5, blk = (lane >> 4) & 1, qq = (lane & 15) >> 2, p = lane & 3;
    const LAS unsigned char* vb = vst + (4 * hi + qq) * 64 + blk * 32 + p * 8;
#pragma unroll
    for (int c = 0; c < 2; ++c)
#pragma unroll
        for (int ks = 0; ks < 2; ++ks) {
            const s16x4 lo = vtr(vb + c * 2048 + (16 * ks) * 64), hh = vtr(vb + c * 2048 + (16 * ks + 8) * 64);
            vf[c][ks] = (bf16x8){lo[0], lo[1], lo[2], lo[3], hh[0], hh[1], hh[2], hh[3]};
        }
}
__device__ __forceinline__ void pv_mma(f32x16 (&o)[2], const bf16x8 (&vf)[2][2], const bf16x8 (&pa)[2]) {
#pragma unroll
    for (int c = 0; c < 2; ++c)
#pragma unroll
        for (int ks = 0; ks < 2; ++ks) o[c] = __builtin_amdgcn_mfma_f32_32x32x16_bf16(vf[c][ks], pa[ks], o[c], 0, 0, 0);
}
__device__ __forceinline__ void pv_tile(f32x16 (&o)[2], const LAS unsigned char* vst, const bf16x8 (&pa)[2], int lane) {
    bf16x8 vf[2][2]; v_frags(vf, vst, lane); pv_mma(o, vf, pa);
}
__device__ __forceinline__ void xp32_store(LAS unsigned char* vst, const v4u (&w)[4], bf16* o0, size_t rstr, int lane) {
    const int r32 = lane & 31, hi = lane >> 5, rt = lane >> 3, ct = lane & 7;
#pragma unroll
    for (int i = 0; i < 4; ++i) *(LAS v4u*)(vst + r32 * 128 + (((4 * hi + i) ^ (r32 & 7)) << 4)) = w[i];
    __builtin_amdgcn_wave_barrier();
    v4u d[4];
#pragma unroll
    for (int j = 0; j < 4; ++j) d[j] = *(const LAS v4u*)(vst + (8 * j + rt) * 128 + ((ct ^ rt) << 4));
    __builtin_amdgcn_wave_barrier();
#pragma unroll
    for (int j = 0; j < 4; ++j) *(GAS v4u*)(o0 + (size_t)(8 * j + rt) * rstr + 8 * ct) = d[j];
}
__device__ __forceinline__ void xp32_load(v4u (&t)[4], const bf16* p0, size_t rstr, int lane) {
    const int rt = lane >> 3, ct = lane & 7;
#pragma unroll
    for (int j = 0; j < 4; ++j) t[j] = *(const GAS v4u*)(p0 + (size_t)(8 * j + rt) * rstr + 8 * ct);
}
__device__ __forceinline__ void xp32_unpack(LAS unsigned char* vst, const v4u (&t)[4], v4u (&w)[4], int lane) {
    const int r32 = lane & 31, hi = lane >> 5, rt = lane >> 3, ct = lane & 7;
#pragma unroll
    for (int j = 0; j < 4; ++j) *(LAS v4u*)(vst + (8 * j + rt) * 128 + ((ct ^ rt) << 4)) = t[j];
    __builtin_amdgcn_wave_barrier();
#pragma unroll
    for (int i = 0; i < 4; ++i) w[i] = *(const LAS v4u*)(vst + r32 * 128 + (((4 * hi + i) ^ (r32 & 7)) << 4));
    __builtin_amdgcn_wave_barrier();
}
__device__ __forceinline__ void attn_store(f32x16 (&o)[2], float inv, LAS float* xs  , LAS unsigned char* vst, bf16* o0  , size_t rstr, int wid, int lane) {
    const int r32 = lane & 31, hi = lane >> 5;
    float ss = 0.f;
#pragma unroll
    for (int c = 0; c < 2; ++c)
#pragma unroll
        for (int r = 0; r < 16; ++r) { o[c][r] *= inv; ss += o[c][r] * o[c][r]; }
    ss += __shfl_xor(ss, 32);
    if (hi == 0) xs[wid * 32 + r32] = ss;
    LDS_WAIT(); __builtin_amdgcn_s_barrier(); asm volatile("" ::: "memory");
    float tot = 0.f;
#pragma unroll
    for (int w = 0; w < 8; ++w) tot += xs[w * 32 + r32];
    const float rstd = 1.0f / sqrtf(tot * (1.0f / 512.0f) + RMS_EPS);
    v4u w4[4];
#pragma unroll
    for (int c = 0; c < 2; ++c)
#pragma unroll
        for (int gp = 0; gp < 2; ++gp)
#pragma unroll
            for (int t = 0; t < 4; ++t) w4[2 * c + gp][t] = pg8::cvt_pk_bf16(o[c][8 * gp + 2 * t] * rstd, o[c][8 * gp + 2 * t + 1] * rstd);
    xp32_store(vst, w4, o0, rstr, lane);
}

__global__ void __launch_bounds__(512, 2) hybrid_fwd(Args args) {
    extern __shared__ __attribute__((aligned(16))) unsigned char lds_raw[];
    LAS unsigned char* lds = (LAS unsigned char*)lds_raw;
    volatile LAS unsigned* MISC = (volatile LAS unsigned*)(lds + MISC_OFF);
    const int G = gridDim.x, bx = blockIdx.x;
    const int wid_s = __builtin_amdgcn_readfirstlane((int)threadIdx.x >> 6);
    const int vcu = (G % 8 == 0) ? (bx % 8) * (G / 8) + bx / 8 : bx;
#define ENV() const __attribute__((address_space(4))) Args* ap = (const __attribute__((address_space(4))) Args*)__builtin_amdgcn_kernarg_segment_ptr(); asm volatile("" : "+s"(ap)); \
    unsigned char* const ws = ap->ws; float* const out = ap->out; (void)out; \
    const int wid = wid_s; unsigned z_ = 0u; asm volatile("" : "+s"(z_)); int tid = wid_s * 64 + (int)__builtin_amdgcn_mbcnt_hi(~0u, __builtin_amdgcn_mbcnt_lo(~0u, z_)); asm volatile("" : "+v"(tid)); const int lane = tid & 63; (void)lane; (void)wid; \
    const int gw = vcu * 8 + wid, NGW = G * 8; (void)gw; (void)NGW
#define IN(i) (ap->in[i])
#define GRID_BAR() do { ENV(); XcdBarrier bar_; bar_.bar = (unsigned*)(ws + WS_CTL) + CW_BAR; bar_.x = xb_xcc_id(); bar_.st = (volatile LAS unsigned*)(lds + MISC_OFF) + 8; xcd_barrier(bar_, wid_s); } while (0)
    {
        ENV();
        for (int u = tid; u < (LDS_BYTES - RING_BYTES) / 4; u += 512) ((LAS unsigned*)(lds + RING_BYTES))[u] = 0u;
        __syncthreads();
        (void)xcd_barrier_post((unsigned*)(ws + WS_CTL) + CW_BAR, MISC + 8);
    }

#pragma unroll 1
    for (int rep = 0; rep < REP_P0; ++rep) {
        ENV();
        const float* x = IN(0); const float* g_attn = IN(1); const float* w_qkv = IN(2); const float* g_out_dil = IN(4); const float* g_out_sb = IN(5); const float* w_o = IN(6); const float* g_moe = IN(7);
        const float* w_gate = IN(10); const float* w_up = IN(12); const float* w_down = IN(14);
        bf16* Wqkv_t = (bf16*)(ws + WS_WQKV); bf16* Wo_t = (bf16*)(ws + WS_WO); unsigned char* Wd8 = ws + WS_WD; unsigned char* Wgu8 = ws + WS_WGU; bf16* XN = (bf16*)(ws + WS_XN);
        constexpr int I_QKV = 16 * 12, I_O = 16 * 4, NSMALL = I_QKV + I_O;
        for (int it = gw; it < NSMALL; it += NGW) {
            int r = it;
            if (r < I_QKV) { const int kb = r / 12, nb = r % 12, n0 = 256 * nb; const float sn = (n0 < 512 || (n0 >= 1536 && n0 < 2048)) ? QSCALE : 1.0f;
                p0_item(w_qkv, NQKV, Wqkv_t + (size_t)(n0 + 4 * lane) * WPITCH, WPITCH, g_attn, sn, 64 * kb, n0, lane); continue; }
            r -= I_QKV;
            { const int kb = r / 4, nb = r % 4, n0 = 256 * nb, k0 = 64 * kb;
                p0_item<true>(w_o, DM, Wo_t + (size_t)(n0 + 4 * lane) * WPITCH, WPITCH, (k0 < 512) ? g_out_dil : (g_out_sb - 512), 1.0f, k0, n0, lane); }
        }
        constexpr int NITEMS = NSMALL + 3 * 2048;
        if (NGW == 2048) { const int heavy = NITEMS - 3 * 2048;
            const int nrow = (gw < heavy) ? 18 : 34, m0 = (gw < heavy) ? gw * 18 : heavy * 18 + (gw - heavy) * 34;
            p0_rows(x, XN, (float*)(ws + WS_RMS1), m0, m0 + nrow, lane);
        } else { for (int m = 2 * gw; m < NTOK; m += 2 * NGW) p0_rows(x, XN, (float*)(ws + WS_RMS1), m, m + 2, lane); }
    }
    GRID_BAR();

#pragma unroll 1
    for (int rep = 0; rep < REP_P1; ++rep) {
        ENV();
        bf16* Wqkv_t = (bf16*)(ws + WS_WQKV); bf16* XN = (bf16*)(ws + WS_XN); bf16* QKV = (bf16*)(ws + WS_QKV);
        pg8::DenseOrder S; S.init(NTOK, NQKV, DM, G, bx, Wqkv_t); if (rep > 0) S.maxi = REP_P1_UNITS;
        pg8::EpiQKV E{QKV, NQKV, lds + XPOSE_OFF};
        pg8::gemm_phase<pg8::EpiQKV, pg8::DenseOrder, false, KREP_P1, EREP_P1>(lds, XN, DM, S, E, wid_s);
    }
    GRID_BAR();

    {
        ENV();
        const float* rel_bias = IN(3); bf16* QKV = (bf16*)(ws + WS_QKV); bf16* OB = (bf16*)(ws + WS_O);
        constexpr int SZ0 = 384, PL0 = 128, SZ1 = 192, PL1 = 32, SZ2 = 192, PL2 = 32;
        LAS unsigned char* vst = lds + wid * KVIMG;
        LAS unsigned char* kst = vst + VIMG;
        LAS float* xsb = (LAS float*)(lds + 8 * KVIMG);
        LAS float* tb0 = xsb + 512; LAS float* tb1 = tb0 + 8 * SZ0; LAS float* tb2 = tb1 + 8 * SZ1;
        const float* g_moe = IN(7); const float* w_gate = IN(10); const float* w_up = IN(12); const float* w_down = IN(14); unsigned char* Wd8 = ws + WS_WD; unsigned char* Wgu8 = ws + WS_WGU;
        int cvt_it = gw;
#define CONV_TILE() do { if (cvt_it < NEXP * 3 * 128) { const int e_ = cvt_it / 384, q_ = cvt_it % 384, m_ = q_ / 128, qq_ = q_ % 128, k0_ = 128 * (qq_ >> 4), n0_ = 64 * (qq_ & 15); \
            if (m_ < 2) p0_tile8((m_ == 0 ? w_gate : w_up) + (size_t)e_ * DM * DEXP, DEXP, Wgu8 + ((size_t)e_ * 2048 + (n0_ >> 7) * 256 + m_ * 128 + (n0_ & 127)) * DM, DM, nullptr, 512.0f, k0_, n0_, vst, lane); \
            else p0_tile8(w_down + (size_t)e_ * DEXP * DM, DM, Wd8 + ((size_t)e_ * DM + n0_) * DEXP, DEXP, nullptr, 512.0f, k0_, n0_, vst, lane); \
            cvt_it += NGW; } } while (0)
        static_assert((8 * (SZ0 + SZ1 + SZ2) + 512) * 4 + 8 * KVIMG <= RING_BYTES, "attention LDS");
        bf16* PB = (bf16*)(ws + WS_X1B);
        float* LS = (float*)(ws + WS_X1B + (size_t)NTOK * 512 * 2);
        for (int i = tid; i < 8 * (SZ0 + SZ1 + SZ2); i += 512) {
            int p, rem; if (i < 8 * SZ0) { p = 0; rem = i; } else if (i < 8 * (SZ0 + SZ1)) { p = 1; rem = i - 8 * SZ0; } else { p = 2; rem = i - 8 * (SZ0 + SZ1); }
            const int sz = p == 0 ? SZ0 : (p == 1 ? SZ1 : SZ2), pl = p == 0 ? PL0 : (p == 1 ? PL1 : PL2), hh = rem / sz, j = rem % sz - pl;
            float v = -1e30f;
            if (j >= 0 && j <= 128) { const int dist = j << (2 * p); int bkt = dist;
                if (dist >= 16) bkt = 16 + (dist >= 22) + (dist >= 30) + (dist >= 40) + (dist >= 54) + (dist >= 73) + (dist >= 99) + (dist >= 134) + (dist >= 182) + (dist >= 246)
                                         + (dist >= 332) + (dist >= 450) + (dist >= 609) + (dist >= 825) + (dist >= 1117) + (dist >= 1513);
                v = rel_bias[bkt * 8 + hh] * LOG2E; }
            tb0[i] = v;
        }
        __syncthreads();
        const int r32 = lane & 31, hi = lane >> 5, h = wid;
        int par = 0;
#define A_LOAD(T, tt_, NT_) A_LOADX(T, tt_, NT_, cr, base)
#define A_LOADX(T, tt_, NT_, cr_, base_) do { const int _t = (tt_) < (NT_) ? (tt_) : (NT_) - 1; A_DESC(_t, _p, _kt); const int _sh = 2 * _p, _kb = (cr_) - (128 << _sh) + ((32 * _kt) << _sh); \
            _Pragma("unroll") for (int _i = 0; _i < 4; ++_i) { int _pos = _kb + ((8 * _i + (lane >> 3)) << _sh); _pos = _pos < 0 ? 0 : (_pos > SEQ - 1 ? SEQ - 1 : _pos); \
                const bf16* _row = (base_) + (size_t)_pos * NQKV + h * 64 + (lane & 7) * 8; T.k[_i] = *(const GAS v4u*)(_row + 512); T.v[_i] = *(const GAS v4u*)(_row + 1024); } } while (0)
#define A_STEP(T, tt_, NT_, QS_) do { if ((tt_) < (NT_)) { A_DESC(tt_, p, kt); const int sh = 2 * p, kbase = cr - (128 << sh) + ((32 * kt) << sh); \
            if (kbase + (31 << sh) >= 0) { \
                kv_put(kst, vst, T, lane); \
                const LAS float* bp = (p == 0 ? tb0 + h * SZ0 + PL0 : (p == 1 ? tb1 + h * SZ1 + PL1 : tb2 + h * SZ2 + PL2)) + (128 - 32 * kt + (((QS_) >> sh) * r32) - 4 * hi - 27); \
                f32x16 bv; _Pragma("unroll") for (int r = 0; r < 16; ++r) bv[r] = bp[27 - ((r & 3) + 8 * (r >> 2))]; \
                bf16x8 vf[2][2]; v_frags(vf, vst, lane); \
                f32x16 s = qk_mma(kst, qf, lane); \
                __builtin_amdgcn_sched_barrier(0);     \
                f32x16 pe = s + bv; \
                if (__builtin_expect(kbase < 0, 0)) { asm volatile("; sequence start: keys before position 0 (a real branch, never if-converted)" ::: "memory"); \
                    _Pragma("unroll") for (int r = 0; r < 16; ++r) if (kbase + ((4 * hi + (r & 3) + 8 * (r >> 2)) << sh) < 0) pe[r] = -1e30f; } \
                float mx = fmaxf(fmaxf(pe[0], pe[1]), pe[2]);     \
                _Pragma("unroll") for (int r = 3; r < 15; r += 2) mx = fmaxf(fmaxf(mx, pe[r]), pe[r + 1]); \
                mx = fmaxf(mx, pe[15]); \
                mx = fmaxf(mx, __shfl_xor(mx, 32)); \
                  \
                  \
                if (__any(mx > m_run + 8.0f)) { const float m_new = fmaxf(m_run, mx), f = __builtin_amdgcn_exp2f(m_run - m_new); m_run = m_new; l_run *= f; \
                    _Pragma("unroll") for (int c = 0; c < 2; ++c) _Pragma("unroll") for (int r = 0; r < 16; ++r) o[c][r] *= f; } \
                _Pragma("unroll") for (int r = 0; r < 16; ++r) { pe[r] = __builtin_amdgcn_exp2f(pe[r] - m_run); l_run += pe[r]; } \
                bf16x8 pa[2]; pa[0] = pack8<0>(pe); pa[1] = pack8<8>(pe); \
                pv_mma(o, vf, pa); } } } while (0)
#define A_PRELOAD(NT_, cr_, base_, qpos_) do { A_LOADX(T0, 0, NT_, cr_, base_); A_LOADX(T1, 1, NT_, cr_, base_); \
            _Pragma("unroll") for (int d0 = 0; d0 < 4; ++d0) qf[d0] = *(const GAS bf16x8*)((base_) + (size_t)(qpos_) * NQKV + h * 64 + d0 * 16 + hi * 8); } while (0)
#define A_STREAM(NT_, QS_) do { \
            constexpr int _TS = (((NT_) - 5) / 3) * 3 + 3; \
            _Pragma("unroll 1") for (int tt = 0; tt + 4 < (NT_); tt += 3) { \
                A_LOAD(T2, tt + 2, NT_); A_STEP(T0, tt, NT_, QS_); \
                A_LOAD(T0, tt + 3, NT_); A_STEP(T1, tt + 1, NT_, QS_); \
                A_LOAD(T1, tt + 4, NT_); A_STEP(T2, tt + 2, NT_, QS_); } \
            if (_TS + 2 < (NT_)) A_LOAD(T2, _TS + 2, NT_); A_STEP(T0, _TS, NT_, QS_); \
            if (_TS + 3 < (NT_)) A_LOAD(T0, _TS + 3, NT_); if (_TS + 1 < (NT_)) A_STEP(T1, _TS + 1, NT_, QS_); \
            if (_TS + 4 < (NT_)) A_LOAD(T1, _TS + 4, NT_); if (_TS + 2 < (NT_)) A_STEP(T2, _TS + 2, NT_, QS_); \
            if (_TS + 3 < (NT_)) A_STEP(T0, _TS + 3, NT_, QS_); \
            static_assert(_TS % 3 == 0 && _TS + 4 >= (NT_) && _TS < (NT_), "stream tail"); } while (0)
#define A_DESC(tt, p_, kt_) const int p_ = 2, kt_ = (tt)
#pragma unroll 1
        for (int rep = 0; rep < REP_A; ++rep) { KVt T0, T1, T2; bf16x8 qf[4]; bool pre = false;
        for (int q = 0; vcu + (q >> 2) * G < BATCH * 16 * 4; ++q) {
            const int sup = vcu + (q >> 2) * G, b = sup >> 6, ch = (sup >> 2) & 15, rho = (sup & 3) + 4 * (q & 3), cr = 512 * ch + rho;
            const int qpos = cr + 16 * r32;
            const bf16* base = QKV + (size_t)b * SEQ * NQKV;
            if (!pre) A_PRELOAD(5, cr, base, qpos);
            f32x16 o[2]; o[0] = f32x16{}; o[1] = f32x16{};
            float m_run = -1e20f, l_run = 0.f;
            A_STREAM(5, 16);
            const bool conv = rep == 0 && ((q + bx) & 3) == 3;
            pre = false && (vcu + ((q + 1) >> 2) * G < BATCH * 16 * 4) && !conv;
            if (pre) { const int supn = vcu + ((q + 1) >> 2) * G, bn = supn >> 6, crn = 512 * ((supn >> 2) & 15) + (supn & 3) + 4 * ((q + 1) & 3); A_PRELOAD(5, crn, QKV + (size_t)bn * SEQ * NQKV, crn + 16 * r32); }
            l_run += __shfl_xor(l_run, 32);
            const float inv = 1.0f / l_run;
            { v4u w4[4];
#pragma unroll
              for (int c = 0; c < 2; ++c)
#pragma unroll
                  for (int gp = 0; gp < 2; ++gp)
#pragma unroll
                      for (int t = 0; t < 4; ++t) w4[2 * c + gp][t] = pg8::cvt_pk_bf16(o[c][8 * gp + 2 * t] * inv, o[c][8 * gp + 2 * t + 1] * inv);
              xp32_store(vst, w4, PB + ((size_t)b * SEQ + cr) * 512 + h * 64, (size_t)16 * 512, lane); }
            if (hi == 0) LS[((size_t)b * SEQ + qpos) * 8 + h] = m_run + __builtin_amdgcn_logf(l_run);
            if (conv) CONV_TILE();
        } }
#undef A_DESC
        bf16x8 Tm[2];
#pragma unroll
        for (int ks = 0; ks < 2; ++ks) { v4u w;
#pragma unroll
            for (int jj = 0; jj < 4; ++jj) { const unsigned a = (crow(8 * ks + 2 * jj, hi) >= r32) ? 0x3F80u : 0u, bq = (crow(8 * ks + 2 * jj + 1, hi) >= r32) ? 0x3F80u : 0u; w[jj] = a | (bq << 16); }
            Tm[ks] = __builtin_bit_cast(bf16x8, w); }
#define B_LOAD(T, k_) B_LOADX(T, k_, base)
#define B_LOADX(T, k_, base_) do { const int _k = (k_) < 0 ? 0 : (k_); \
            _Pragma("unroll") for (int _i = 0; _i < 4; ++_i) { const bf16* _row = (base_) + (size_t)(_k + 8 * _i + (lane >> 3)) * NQKV + h * 64 + (lane & 7) * 8; \
                T.k[_i] = *(const GAS v4u*)(_row + 2048); T.v[_i] = *(const GAS v4u*)(_row + 2560); } } while (0)
#define B_STEP(T, k0, DIAG) do { \
            kv_put(kst, vst, T, lane); \
            f32x16 z = qk_mma(kst, qf, lane); \
            f32x16 sp; \
            _Pragma("unroll") for (int r = 0; r < 16; ++r) { z[r] = fminf(z[r], 126.0f); \
                const float v = __builtin_amdgcn_logf(1.0f + __builtin_amdgcn_exp2f(z[r])); \
                sp[r] = (!(DIAG) || ((k0) + crow(r, hi)) < qpos) ? v : 0.f; } \
            bf16x8 sb[2]; sb[0] = pack8<0>(sp); sb[1] = pack8<8>(sp); \
            f32x16 cs; \
            _Pragma("unroll") for (int r = 0; r < 16; ++r) cs[r] = carry; \
            cs = __builtin_amdgcn_mfma_f32_32x32x16_bf16(Tm[0], sb[0], cs, 0, 0, 0); \
            cs = __builtin_amdgcn_mfma_f32_32x32x16_bf16(Tm[1], sb[1], cs, 0, 0, 0); \
            f32x16 pe; \
            _Pragma("unroll") for (int r = 0; r < 16; ++r) { const float v = __builtin_amdgcn_exp2f(z[r] - cs[r]); pe[r] = (!(DIAG) || ((k0) + crow(r, hi)) < qpos) ? v : 0.f; } \
            bf16x8 pa[2]; pa[0] = pack8<0>(pe); pa[1] = pack8<8>(pe); \
            pv_tile(o, vst, pa, lane); \
            carry = __shfl(cs[0], r32); } while (0)
#define B_DONE(k0) ((k0) == 0 || __all(carry > 150.0f))
#pragma unroll 1
        for (int rep = 0; rep < REP_B; ++rep) { KVt T0, T1, T2; bf16x8 qf[4]; bool pre = false;
#define B_PRELOAD(t0_, base_, qpos_) do { B_LOADX(T0, t0_, base_); B_LOADX(T1, (t0_) - 32, base_); \
            _Pragma("unroll") for (int d0 = 0; d0 < 4; ++d0) qf[d0] = *(const GAS bf16x8*)((base_) + (size_t)(qpos_) * NQKV + 1536 + h * 64 + d0 * 16 + hi * 8); } while (0)
        for (int item = vcu; item < BATCH * (SEQ / 32); item += G, par ^= 1) {
            const int b = item >> 8, qt = item & 255, t0 = 32 * qt, qpos = t0 + r32;
            const bf16* base = QKV + (size_t)b * SEQ * NQKV;
            if (!pre) B_PRELOAD(t0, base, qpos);
            f32x16 o[2]; o[0] = f32x16{}; o[1] = f32x16{};
            float carry = 0.f;
            int k0 = t0;
            B_LOAD(T2, k0 - 64); B_STEP(T0, k0, true);
            if (!B_DONE(k0)) { k0 -= 32;
#pragma unroll 1
                for (;;) {
                    B_LOAD(T0, k0 - 64); B_STEP(T1, k0, false); if (B_DONE(k0)) break; k0 -= 32;
                    B_LOAD(T1, k0 - 64); B_STEP(T2, k0, false); if (B_DONE(k0)) break; k0 -= 32;
                    B_LOAD(T2, k0 - 64); B_STEP(T0, k0, false); if (B_DONE(k0)) break; k0 -= 32;
                } }
            const bool conv = rep == 0 && ((((item - vcu) / G) + bx) & 3) == 3;
            pre = (item + G < BATCH * (SEQ / 32)) && !conv;
            if (pre) { const int itn = item + G, bn = itn >> 8, t0n = 32 * (itn & 255); B_PRELOAD(t0n, QKV + (size_t)bn * SEQ * NQKV, t0n + r32); }
            attn_store(o, 1.0f, xsb + par * 256, vst, OB + ((size_t)b * SEQ + (qpos - r32)) * DM + 512 + h * 64, (size_t)DM, wid, lane);
            if (conv) CONV_TILE();
        } }
#undef B_PRELOAD
#undef B_LOADX
#undef B_LOAD
#undef B_STEP
#undef B_DONE
        VM_WAIT();
#define A_DESC(tt, p_, kt_) const int p_ = ((tt) >= 8) ? 1 : 0, kt_ = (tt) - (p_ ? 8 : 0)
#pragma unroll 1
        for (int rep = 0; rep < REP_A; ++rep) { KVt T0, T1, T2; bf16x8 qf[4]; bool pre = false;
        for (int q = 0; vcu + (q >> 2) * G < BATCH * 16 * 4; ++q, par ^= 1) {
            const int sup = vcu + (q >> 2) * G, b = sup >> 6, blk = 4 * ((sup >> 2) & 15) + (q & 3), rho = sup & 3, cr = 128 * blk + rho;
            const int qpos = cr + 4 * r32;
            const bf16* base = QKV + (size_t)b * SEQ * NQKV;
            if (!pre) A_PRELOAD(13, cr, base, qpos);
            f32x16 o[2]; o[0] = f32x16{}; o[1] = f32x16{};
            float m_run = -1e20f, l_run = 0.f;
            v4u pt[4];
            xp32_load(pt, PB + ((size_t)b * SEQ + cr) * 512 + h * 64, (size_t)4 * 512, lane);
            const float lse3 = LS[((size_t)b * SEQ + qpos) * 8 + h];
            A_STREAM(13, 4);
            const bool conv = rep == 0 && ((q + bx) & 3) == 3;
            pre = false && (vcu + ((q + 1) >> 2) * G < BATCH * 16 * 4) && !conv;
            if (pre) { const int supn = vcu + ((q + 1) >> 2) * G, bn = supn >> 6, crn = 128 * (4 * ((supn >> 2) & 15) + ((q + 1) & 3)) + (supn & 3); A_PRELOAD(13, crn, QKV + (size_t)bn * SEQ * NQKV, crn + 4 * r32); }
            l_run += __shfl_xor(l_run, 32);
            { v4u pw4[4]; xp32_unpack(vst, pt, pw4, lane);
              const float m = fmaxf(m_run, lse3), a12 = __builtin_amdgcn_exp2f(m_run - m), a3 = __builtin_amdgcn_exp2f(lse3 - m);
              l_run = l_run * a12 + a3;
#pragma unroll
              for (int c = 0; c < 2; ++c)
#pragma unroll
                  for (int gp = 0; gp < 2; ++gp)
#pragma unroll
                      for (int t = 0; t < 4; ++t) { o[c][8 * gp + 2 * t] = o[c][8 * gp + 2 * t] * a12 + bflo(pw4[2 * c + gp][t]) * a3; o[c][8 * gp + 2 * t + 1] = o[c][8 * gp + 2 * t + 1] * a12 + bfhi(pw4[2 * c + gp][t]) * a3; } }
            attn_store(o, 1.0f / l_run, xsb + par * 256, vst, OB + ((size_t)b * SEQ + cr) * DM + h * 64, (size_t)4 * DM, wid, lane);
            if (conv) CONV_TILE();
        } }
        while (cvt_it < NEXP * 3 * 128) CONV_TILE();
#undef CONV_TILE
#undef A_DESC
#undef A_LOAD
#undef A_LOADX
#undef A_PRELOAD
#undef A_STEP
#undef A_STREAM
    }
    GRID_BAR();

#pragma unroll 1
    for (int rep = 0; rep < REP_P3; ++rep) {
        ENV();
        bf16* Wo_t = (bf16*)(ws + WS_WO); bf16* OB = (bf16*)(ws + WS_O); bf16* X1B = (bf16*)(ws + WS_X1B); unsigned char* X1Q = ws + WS_X1Q;
        pg8::DenseOrder S; S.init(NTOK, DM, DM, G, bx, Wo_t);
        pg8::EpiWo E{(const pg8::bf16_t*)(ws + WS_XN), (const float*)(ws + WS_RMS1), X1B, X1Q, IN(7)};
        pg8::gemm_phase<pg8::EpiWo, pg8::DenseOrder>(lds, OB, DM, S, E, wid_s);
    }
    GRID_BAR();

    {
        ENV();
        const float* g_moe = IN(7); const float* w_router = IN(8); const float* b_router = IN(9); const bf16* X1B = (const bf16*)(ws + WS_X1B);
        int* tok_list = (int*)(ws + WS_TOK); float* gate_list = (float*)(ws + WS_GATE); float* rs_list = (float*)(ws + WS_RS); int* dst_list = (int*)(ws + WS_DST);
        unsigned* cnt_g = (unsigned*)(ws + WS_CTL) + CW_CNT;
        LAS unsigned short* Wt = (LAS unsigned short*)lds;
        LAS unsigned* hist = (LAS unsigned*)(lds + HIST_OFF); LAS unsigned* basel = (LAS unsigned*)(lds + BASE_OFF);
        for (int s = tid; s < DM * NEXP; s += 512) { const int k = s >> 5, e = s & 31; const float w = g_moe[k] * w_router[s];
            const unsigned wh = f2bf(w); const unsigned wl_ = f2bf(w - __builtin_bit_cast(float, wh << 16));
            const int idx = (((k >> 4) * 2 + ((k >> 3) & 1)) * 32 + e) * 16 + (k & 7); Wt[idx] = (unsigned short)wh; Wt[idx + 8] = (unsigned short)wl_; }
        if (tid < 32) hist[tid] = 0u;
        __syncthreads();
        const int r32 = lane & 31, hi = lane >> 5;
        for (int chunk = bx; chunk < NTOK / 256; chunk += G) {
            const int row = chunk * 256 + wid * 32 + r32;
            const GAS v4u* xr = (const GAS v4u*)(X1B + (size_t)row * DM + 8 * hi);
            const LAS bf16x8* wl = (const LAS bf16x8*)Wt + (hi * 32 + r32) * 2;
            f32x16 acc = {}; float ssq = 0.f;
#pragma unroll 4
            for (int i = 0; i < 64; ++i) { const v4u xv = xr[2 * i]; const bf16x8 wh = wl[i * 128], wlo = wl[i * 128 + 1];
                const bf16x8 xb = __builtin_bit_cast(bf16x8, xv);
                acc = __builtin_amdgcn_mfma_f32_32x32x16_bf16(wh, xb, acc, 0, 0, 0); acc = __builtin_amdgcn_mfma_f32_32x32x16_bf16(wlo, xb, acc, 0, 0, 0);
                const float v0 = bflo(xv.x), v1 = bfhi(xv.x), v2 = bflo(xv.y), v3 = bfhi(xv.y), v4 = bflo(xv.z), v5 = bfhi(xv.z), v6 = bflo(xv.w), v7 = bfhi(xv.w);
                ssq += ((v0 * v0 + v1 * v1) + (v2 * v2 + v3 * v3)) + ((v4 * v4 + v5 * v5) + (v6 * v6 + v7 * v7)); }
            ssq += __shfl_xor(ssq, 32);
            const float rstd2 = 1.0f / sqrtf(ssq * (1.0f / DM) + RMS_EPS);
            float lg[16];
#pragma unroll
            for (int r = 0; r < 16; ++r) lg[r] = acc[r] * rstd2 + b_router[crow(r, hi)];
            float tv[4]; int ti[4];
#pragma unroll
            for (int k = 0; k < 4; ++k) {
                float bv = lg[0]; int bi = crow(0, hi);
#pragma unroll
                for (int r = 1; r < 16; ++r) { if (lg[r] > bv) { bv = lg[r]; bi = crow(r, hi); } }
                const float pv = __shfl_xor(bv, 32); const int pi = __shfl_xor(bi, 32);
                const bool mine = (bv > pv) || (bv == pv && bi < pi);
                tv[k] = mine ? bv : pv; ti[k] = mine ? bi : pi;
#pragma unroll
                for (int r = 0; r < 16; ++r) if (mine && crow(r, hi) == bi) lg[r] = -3.0e38f;
            }
            float ge[4]; float gs = 0.f;
#pragma unroll
            for (int k = 0; k < 4; ++k) { ge[k] = __builtin_amdgcn_exp2f((tv[k] - tv[0]) * LOG2E); gs += ge[k]; }
            const float ginv = 1.0f / gs;
            unsigned rank[4] = {0u, 0u, 0u, 0u};
            if (hi == 0) {
#pragma unroll
                for (int k = 0; k < 4; ++k) rank[k] = __hip_atomic_fetch_add(hist + ti[k], 1u, __ATOMIC_RELAXED, __HIP_MEMORY_SCOPE_WORKGROUP);
            }
            __syncthreads();
            if (tid < 32) basel[tid] = __hip_atomic_fetch_add(cnt_g + tid, hist[tid], RLX_AGENT);
            __syncthreads();
            if (hi == 0) {
#pragma unroll
                for (int k = 0; k < 4; ++k) { const size_t li = (size_t)ti[k] * NTOK + basel[ti[k]] + rank[k];
                    tok_list[li] = row; gate_list[li] = ge[k] * ginv; rs_list[li] = rstd2; dst_list[li] = row * 4 + k; }
            }
            __syncthreads();
            if (tid < 32) hist[tid] = 0u;
            __syncthreads();
        }
    }
    GRID_BAR();

    LAS int* cntl = (LAS int*)(lds + CNTL_OFF); LAS int* firstl = (LAS int*)(lds + FIRST_OFF); LAS int* rbtab = (LAS int*)(lds + RBTAB_OFF);
    {
    ENV();
    unsigned* cnt_g = (unsigned*)(ws + WS_CTL) + CW_CNT;
    if (tid < 64) {
        int c = 0; if (tid < 32) c = (int)__hip_atomic_load(cnt_g + tid, RLX_AGENT);
        const int nrb = (c + 255) >> 8; int inc = nrb;
#pragma unroll
        for (int o = 1; o < 32; o <<= 1) { const int t = __shfl_up(inc, o); if ((tid & 31) >= o) inc += t; }
        if (tid < 32) { cntl[tid] = c; firstl[tid] = inc - nrb; if (tid == 31) firstl[32] = inc; }
    }
    __syncthreads();
    const int nRB0 = firstl[32];
    for (int rb = tid; rb < nRB0; rb += 512) { int e = 0;
#pragma unroll 1
        for (int q = 1; q < 32; ++q) e += (firstl[q] <= rb) ? 1 : 0;
        rbtab[rb] = (e << 16) | (rb - firstl[e]); }
    __syncthreads();
    }
    const int nRB = __builtin_amdgcn_readfirstlane(firstl[32]);

#pragma unroll 1
    for (int rep = 0; rep < REP_P5; ++rep) {
        ENV();
        const float* b_gate = IN(11); const float* b_up = IN(13); unsigned char* Wgu8 = ws + WS_WGU; unsigned char* X1Q = ws + WS_X1Q; unsigned char* ACT = ws + WS_ACT;
        int* tok_list = (int*)(ws + WS_TOK); float* rs_list = (float*)(ws + WS_RS);
        pg8::MoeOrder<true> S{G, bx, 8, nRB, DM / 2, (const char*)Wgu8, (size_t)2048 * DM, rbtab, cntl, tok_list, lds + UTAB_OFF, rs_list, nullptr, b_gate, b_up};
        pg8::EpiGU E{ACT, lds + UTAB_OFF};
        pg8::gemm_phase<pg8::EpiGU, pg8::MoeOrder<true>, true, 1, 1, false>(lds, X1Q, DM / 2, S, E, wid_s);
    }
    GRID_BAR();

#pragma unroll 1
    for (int rep = 0; rep < REP_P6; ++rep) {
        ENV();
        const float* b_down = IN(15); unsigned char* Wd8 = ws + WS_WD; unsigned char* ACT = ws + WS_ACT;
        float* gate_list = (float*)(ws + WS_GATE); int* dst_list = (int*)(ws + WS_DST);
        pg8::MoeOrder<false> S{G, bx, 4, nRB, DEXP / 2, (const char*)Wd8, (size_t)DM * DEXP, rbtab, cntl, nullptr, lds + UTAB_OFF, gate_list, dst_list, b_down, nullptr};
        pg8::EpiDown E{(unsigned char*)out, lds + UTAB_OFF};
        pg8::gemm_phase<pg8::EpiDown, pg8::MoeOrder<false>, true, 1, 1, false>(lds, ACT, DEXP / 2, S, E, wid_s);
    }
    GRID_BAR();

    {
        ENV();
        const float* g_final = IN(16); bf16* X1B = (bf16*)(ws + WS_X1B); const unsigned char* Y = (const unsigned char*)out;
        f32x4 gf[4];
#pragma unroll
        for (int q = 0; q < 4; ++q) gf[q] = *(const f32x4*)(g_final + 16 * lane + 4 * q);
#define P7_LOAD(XA, YA, M0) do { _Pragma("unroll") for (int t = 0; t < 2; ++t) { \
                _Pragma("unroll") for (int j = 0; j < 2; ++j) XA[t][j] = *(const GAS v4u*)(X1B + (size_t)((M0) + t) * DM + 16 * lane + 8 * j); \
                _Pragma("unroll") for (int k = 0; k < 4; ++k) YA[t][k] = *(const GAS v4u*)(Y + ((size_t)((M0) + t) * 4 + k) * DM + 16 * lane); } } while (0)
        v4u xa[2][2], ya[2][4], xn2[2][2], yn2[2][4];
        if (2 * gw < NTOK) P7_LOAD(xa, ya, 2 * gw);
#pragma unroll 1
        for (int m0 = 2 * gw; m0 < NTOK; m0 += 2 * NGW) {
            const bool more = m0 + 2 * NGW < NTOK;
            if (more) P7_LOAD(xn2, yn2, m0 + 2 * NGW);
#pragma unroll
            for (int t = 0; t < 2; ++t) {
                float v[16]; float s2 = 0.f;
#pragma unroll
                for (int q = 0; q < 4; ++q) {
                    float y0 = 0.f, y1 = 0.f, y2 = 0.f, y3 = 0.f;
#pragma unroll
                    for (int k = 0; k < 4; ++k) { const auto lo = __builtin_amdgcn_cvt_pk_f32_fp8((int)ya[t][k][q], false), hh = __builtin_amdgcn_cvt_pk_f32_fp8((int)ya[t][k][q], true);
                        y0 += lo[0]; y1 += lo[1]; y2 += hh[0]; y3 += hh[1]; }
                    const unsigned w0 = xa[t][q >> 1][(q & 1) * 2], w1 = xa[t][q >> 1][(q & 1) * 2 + 1];
                    v[4 * q] = bflo(w0) + y0 * (1.0f / 8.0f); v[4 * q + 1] = bfhi(w0) + y1 * (1.0f / 8.0f); v[4 * q + 2] = bflo(w1) + y2 * (1.0f / 8.0f); v[4 * q + 3] = bfhi(w1) + y3 * (1.0f / 8.0f);
                    s2 += (v[4 * q] * v[4 * q] + v[4 * q + 1] * v[4 * q + 1]) + (v[4 * q + 2] * v[4 * q + 2] + v[4 * q + 3] * v[4 * q + 3]); }
                const float rstd = 1.0f / sqrtf(wave_sum(s2) * (1.0f / DM) + RMS_EPS);
                GAS f32x4* op = (GAS f32x4*)(out + (size_t)(m0 + t) * DM + 16 * lane);
#pragma unroll
                for (int q = 0; q < 4; ++q) op[q] = (f32x4){v[4 * q] * rstd * gf[q].x, v[4 * q + 1] * rstd * gf[q].y, v[4 * q + 2] * rstd * gf[q].z, v[4 * q + 3] * rstd * gf[q].w};
            }
            if (more) {
#pragma unroll
                for (int t = 0; t < 2; ++t) {
#pragma unroll
                    for (int j = 0; j < 2; ++j) xa[t][j] = xn2[t][j];
#pragma unroll
                    for (int k = 0; k < 4; ++k) ya[t][k] = yn2[t][k]; } }
        }
#undef P7_LOAD
    }
}

extern "C" void kernel_launch(void* const* d_in, const int* in_sizes, int n_in, void* d_out, int out_size, void* d_ws, size_t ws_size, hipStream_t stream) {
    static int grid = 0;
    if (grid == 0) {
        if (n_in != 17 || out_size != NTOK * DM || ws_size < WS_END) { fprintf(stderr, "kernel_launch: unexpected shapes (n_in %d, out %d, ws %zu)\n", n_in, out_size, ws_size); grid = -1; return; }
        int dev = 0, cus = 0;
        if (hipGetDevice(&dev) != hipSuccess || hipDeviceGetAttribute(&cus, hipDeviceAttributeMultiprocessorCount, dev) != hipSuccess) { grid = -1; return; }
        if (hipFuncSetAttribute((const void*)hybrid_fwd, hipFuncAttributeMaxDynamicSharedMemorySize, LDS_BYTES) != hipSuccess) { grid = -1; return; }
        int per_cu = 0;
        if (hipOccupancyMaxActiveBlocksPerMultiprocessor(&per_cu, (const void*)hybrid_fwd, 512, LDS_BYTES) != hipSuccess || per_cu < 1) { fprintf(stderr, "kernel_launch: occupancy query says %d\n", per_cu); }
        (void)hipGetLastError();
        grid = cus;
    }
    if (grid < 0) return;
    if (hipMemsetAsync((char*)d_ws + WS_CTL, 0, CTL_ZERO_BYTES, stream) != hipSuccess) return;
    Args a{};
    for (int i = 0; i < 17; ++i) a.in[i] = (const float*)d_in[i];
    a.out = (float*)d_out; a.ws = (unsigned char*)d_ws;
    hipLaunchKernelGGL(hybrid_fwd, dim3(grid), dim3(512), LDS_BYTES, stream, a);
}
```

```cpp
#include <hip/hip_runtime.h>
#include <cstdio>
#include <cstdint>

#define GAS __attribute__((address_space(1)))
#define LAS __attribute__((address_space(3)))
#ifndef REP_P0
#define REP_P0 1
#endif
#ifndef REP_P1
#define REP_P1 1
#endif
#ifndef REP_A
#define REP_A 1
#endif
#ifndef REP_B
#define REP_B 1
#endif
#ifndef REP_P3
#define REP_P3 1
#endif
#ifndef REP_P5
#define REP_P5 1
#endif
#ifndef REP_P6
#define REP_P6 1
#endif
#ifndef KREP_P1
#define KREP_P1 1
#endif
#ifndef EREP_P1
#define EREP_P1 1
#endif
#ifndef REP_P1_UNITS
#define REP_P1_UNITS 12
#endif
#ifndef KREP_P5
#define KREP_P5 1
#endif

constexpr int BATCH = 8, SEQ = 8192, DM = 1024, NTOK = BATCH * SEQ;
constexpr int NQKV = 3072, NEXP = 32, TOPK = 4, DEXP = 1024;
constexpr int MAXRB = NTOK * TOPK / 256 + NEXP;
constexpr int NSLOT = MAXRB * 256;
constexpr float RMS_EPS = 1e-6f;
constexpr float LOG2E = 1.4426950408889634f;
constexpr float QSCALE = 0.125f * LOG2E;

namespace pg8 {
#define PG8_LAS __attribute__((address_space(3)))
typedef unsigned short bf16_t;
typedef short bf16x8 __attribute__((ext_vector_type(8)));
typedef float f32x4 __attribute__((ext_vector_type(4)));
typedef unsigned u32x4 __attribute__((ext_vector_type(4)));
typedef unsigned u32x2 __attribute__((ext_vector_type(2)));
constexpr int BM = 256, BK = 64, HALF = 128, HTB = HALF * BK * 2, STAGE_BYTES = 8 * HTB, NXCD = 8, WGM = 8;

__host__ __device__ __forceinline__ int lds_chunk(int r, int c) { return (r >> 3) * 1024 + (r & 7) * 128 + ((c ^ ((r >> 1) & 7)) << 4); }
__host__ __device__ __forceinline__ void stage_rc(int b, int& R, int& C) { R = (b >> 10) * 8 + ((b >> 7) & 7); C = ((((b >> 4) & 7) ^ ((R >> 1) & 7))) * 8; }
__host__ __device__ __forceinline__ int perm32(int rho) { const int n = rho >> 4, i = rho & 15; return 8 * (i >> 2) + 4 * n + (i & 3); }

__device__ __forceinline__ int lane_now() { unsigned z = 0u; asm volatile("" : "+s"(z)); return (int)__builtin_amdgcn_mbcnt_hi(~0u, __builtin_amdgcn_mbcnt_lo(~0u, z)); }
struct Unit { int pm, pn, e, r0, nv; };

typedef float f32x2_cv __attribute__((ext_vector_type(2))); typedef __bf16 bf16x2_cv __attribute__((ext_vector_type(2)));
__device__ __forceinline__ unsigned cvt_pk_bf16(float lo, float hi) { const f32x2_cv v = {lo, hi}; const bf16x2_cv b = __builtin_convertvector(v, bf16x2_cv); return __builtin_bit_cast(unsigned, b); }

struct DenseOrder {
    int nM, nN, nwg, G, c, K; const char* Bt; int maxi = 1 << 30;
    __device__ void init(int M, int N, int K_, int G_, int c_, const void* Bt_) { nM = M / BM; nN = N / BM; nwg = nM * nN; G = G_; c = c_; K = K_; Bt = (const char*)Bt_; }
    __device__ __forceinline__ bool next(int i, Unit& u) const {
        const long L = (long)i * G + c; if (L >= nwg || i >= maxi) return false;
        int wgid = (int)L; { const int q = nwg / NXCD, r = nwg % NXCD, xcd = wgid % NXCD, off = wgid / NXCD; wgid = (xcd < r ? xcd * (q + 1) : r * (q + 1) + (xcd - r) * q) + off; }
        const int nig = WGM * nN, gid = wgid / nig, fm = gid * WGM, gsz = (nM - fm) < WGM ? (nM - fm) : WGM;
        u.pm = fm + ((wgid % nig) % gsz); u.pn = (wgid % nig) / gsz; u.e = 0; u.r0 = 0; u.nv = 256; return true;
    }
    static constexpr bool GATHER = false;
    static constexpr int BPAD = 64;
    __device__ __forceinline__ const char* bbase(const Unit& u) const { return Bt + (size_t)u.pn * BM * (K + BPAD) * 2; }
    __device__ __forceinline__ size_t abase(const Unit& u) const { return (size_t)u.pm * BM * K * 2; }
    __device__ __forceinline__ void aoffs(const Unit&, int, unsigned (&)[2][2]) const {}
    __device__ __forceinline__ void aoffs_lds(const Unit&, int, int, unsigned (&)[2][2]) const {}
    __device__ __forceinline__ void unit_begin(const Unit&, const Unit&, bool, int, int, int) const {}
};
constexpr int UT_TOK = 0, UT_ROWA = 1024, UT_ROWB = 2048, UT_BIAS = 3072, UT_BYTES = 4096;
template <bool GATHER_> struct MoeOrder {
    static constexpr bool GATHER = GATHER_; static constexpr int BPAD = 0;
    int G, c, NT, nRB, K; const char* W; size_t wstride; const PG8_LAS int* rbtab; const PG8_LAS int* cntl; const int* tok_list;
    PG8_LAS unsigned char* utab;
    const float* rowa; const int* rowb; const float* bias0; const float* bias1;
    __device__ __forceinline__ bool next(int i, Unit& u) const {
        const int L = i * G + c, per = 8 * NT, grp = L / per, rem = L % per, j = rem >> 3, rb = grp * 8 + (rem & 7);
        if (rb >= nRB) return false;
        const int pk = __builtin_amdgcn_readfirstlane(rbtab[rb]); u.e = pk >> 16; u.pm = rb; u.pn = j; u.r0 = (pk & 0xffff) * 256;
        const int left = __builtin_amdgcn_readfirstlane(cntl[u.e]) - u.r0; u.nv = left < 256 ? left : 256; return true;
    }
    __device__ __forceinline__ const char* bbase(const Unit& u) const { return W + (size_t)u.e * wstride + (size_t)u.pn * BM * K * 2; }
    __device__ __forceinline__ size_t abase(const Unit& u) const { return GATHER ? (size_t)0 : (size_t)u.pm * BM * K * 2; }
    __device__ __forceinline__ void aoffs(const Unit& u, int tid, unsigned (&o)[2][2]) const {
        if (GATHER) {
            asm volatile("" : "+v"(tid));
            int tok[2][2];
#pragma unroll
            for (int i = 0; i < 2; ++i) { int R, C; stage_rc(tid * 16 + i * 8192, R, C);
#pragma unroll
                for (int h = 0; h < 2; ++h) { const int rl = h * HALF + R, rc = rl < u.nv ? rl : u.nv - 1; tok[h][i] = tok_list[(size_t)u.e * NTOK + u.r0 + rc]; } }
#pragma unroll
            for (int i = 0; i < 2; ++i) { int R, C; stage_rc(tid * 16 + i * 8192, R, C);
#pragma unroll
                for (int h = 0; h < 2; ++h) o[h][i] = (unsigned)(tok[h][i] * K + C) * 2u; }
        }
    }
    __device__ __forceinline__ void aoffs_lds(const Unit& u, int wid, int ui, unsigned (&o)[2][2]) const {
        if (GATHER) {
            const int tid = wid * 64 + lane_now();
            const PG8_LAS int* tt = (const PG8_LAS int*)(utab + (ui & 1) * UT_BYTES + UT_TOK);
#pragma unroll
            for (int i = 0; i < 2; ++i) { int R, C; stage_rc(tid * 16 + i * 8192, R, C);
#pragma unroll
                for (int h = 0; h < 2; ++h) { const int rl = h * HALF + R; const int tok = rl < u.nv ? tt[rl] : 0; o[h][i] = (unsigned)(tok * K + C) * 2u; } }
        }
    }
    __device__ __forceinline__ void unit_begin(const Unit& cur, const Unit& nxt, bool has_next, int ui, int wid, int lane) const {
        PG8_LAS unsigned char* tb = utab + (ui & 1) * UT_BYTES;
        const size_t li = (size_t)cur.e * NTOK + cur.r0;
        (void)lane;
        const unsigned lo = (unsigned)lane_now() * 4u;
#define PG8_DMA4(gptr, ldsptr) __builtin_amdgcn_global_load_lds((const unsigned*)((const char*)(gptr) + lo), (PG8_LAS unsigned*)(ldsptr), 4, 0, 0)
        if (wid < 4) {
            PG8_DMA4(rowa + li + 64 * wid, tb + UT_ROWA + 256 * wid);
            if (GATHER && has_next) PG8_DMA4(tok_list + (size_t)nxt.e * NTOK + nxt.r0 + 64 * wid, tb + UT_TOK + 256 * wid);
        } else {
            const int q = wid - 4;
            if (GATHER) PG8_DMA4((q < 2 ? bias0 : bias1) + (size_t)cur.e * DEXP + cur.pn * HALF + 64 * (q & 1), tb + UT_BIAS + 256 * q);
            else { PG8_DMA4(bias0 + (size_t)cur.e * DM + cur.pn * BM + 64 * q, tb + UT_BIAS + 256 * q);
                PG8_DMA4(rowb + li + 64 * q, tb + UT_ROWB + 256 * q); }
        }
#undef PG8_DMA4
    }
};

struct XposeRows {
    PG8_LAS unsigned char* xw; int wa, rd;
    __device__ __forceinline__ void init(PG8_LAS unsigned char* xs, int wid, int fr, int fq) { const int lane = fq * 16 + fr; xw = xs + wid * 2048;
        wa = fr * 128 + (((2 * fq) ^ (fr & 7)) << 4); rd = (lane >> 3) * 128 + (((lane & 7) ^ (lane >> 3)) << 4); }
    __device__ __forceinline__ void run(const u32x4& a0, const u32x4& a1, u32x4& d0, u32x4& d1) const {
        *(PG8_LAS u32x4*)(xw + wa) = a0; *(PG8_LAS u32x4*)(xw + (wa ^ 16)) = a1;
        __builtin_amdgcn_wave_barrier();
        d0 = *(const PG8_LAS u32x4*)(xw + rd); d1 = *(const PG8_LAS u32x4*)(xw + rd + 1024);
        __builtin_amdgcn_wave_barrier(); }
};
struct EpiQKV {
    static constexpr bool PERM = true, PERM16 = true; static constexpr int NSTORE = 16;
    bf16_t* O; int ldc; PG8_LAS unsigned char* xs;
    __device__ __forceinline__ void operator()(const f32x4 (&acc)[2][2][4][2], const Unit& u, int, int wr, int wc, int fr, int fq) const {
        const int lane = fq * 16 + fr;
        XposeRows X; X.init(xs, wr * 4 + wc, fr, fq);
        bf16_t* const p0 = O + (size_t)(u.pm * BM + wr * 64 + (lane >> 3)) * ldc + u.pn * BM + wc * 64 + 8 * (lane & 7);
#pragma unroll
        for (int ai = 0; ai < 2; ++ai)
#pragma unroll
            for (int m = 0; m < 4; ++m) { bf16_t* rowp = p0 + (size_t)(ai * HALF + m * 16) * ldc;
                u32x4 own[2];
#pragma unroll
                for (int bj = 0; bj < 2; ++bj) { const f32x4 v0 = acc[ai][bj][m][0] * (1.0f / KREP_P1), v1 = acc[ai][bj][m][1] * (1.0f / KREP_P1);
                    own[bj].x = cvt_pk_bf16(v0[0], v0[1]); own[bj].y = cvt_pk_bf16(v0[2], v0[3]); own[bj].z = cvt_pk_bf16(v1[0], v1[1]); own[bj].w = cvt_pk_bf16(v1[2], v1[3]); }
                u32x4 d0, d1; X.run(own[0], own[1], d0, d1);
                *(u32x4*)rowp = d0; *(u32x4*)(rowp + (size_t)8 * ldc) = d1; }
    }
};
struct EpiWo {
    static constexpr bool PERM = true, PERM16 = true; static constexpr int NSTORE = 24;
    const bf16_t* XNp; const float* RMS; bf16_t* X1b; unsigned char* X1q; const float* GM;
    __device__ __forceinline__ void operator()(const f32x4 (&acc)[2][2][4][2], const Unit& u, int, int wr, int wc, int fr, int fq) const {
        const int row0 = u.pm * BM + wr * 64 + fr, col0 = u.pn * BM + wc * 64 + 16 * fq;
        f32x4 gm[2][2];
#pragma unroll
        for (int bj = 0; bj < 2; ++bj)
#pragma unroll
            for (int n = 0; n < 2; ++n) gm[bj][n] = *(const f32x4*)(GM + col0 + 8 * bj + 4 * n);
#pragma unroll
        for (int ai = 0; ai < 2; ++ai)
#pragma unroll
            for (int m = 0; m < 4; ++m) { const int row = row0 + ai * HALF + m * 16; const size_t off = (size_t)row * DM + col0; const float rms = RMS[row];
                int q8[4];
#pragma unroll
                for (int bj = 0; bj < 2; ++bj) { const size_t o2 = off + 8 * bj; const u32x4 xw = *(const u32x4*)(XNp + o2);
                    float v[8];
#pragma unroll
                    for (int q = 0; q < 4; ++q) { v[2 * q] = __builtin_bit_cast(float, xw[q] << 16) * rms + acc[ai][bj][m][q >> 1][(q & 1) * 2]; v[2 * q + 1] = __builtin_bit_cast(float, xw[q] & 0xffff0000u) * rms + acc[ai][bj][m][q >> 1][(q & 1) * 2 + 1]; }
                    u32x4 w; w.x = cvt_pk_bf16(v[0], v[1]); w.y = cvt_pk_bf16(v[2], v[3]); w.z = cvt_pk_bf16(v[4], v[5]); w.w = cvt_pk_bf16(v[6], v[7]); *(u32x4*)(X1b + o2) = w;
                    const f32x4 g0 = gm[bj][0], g1 = gm[bj][1];
                    int q0 = 0, q1 = 0; q0 = __builtin_amdgcn_cvt_pk_fp8_f32(v[0] * g0[0], v[1] * g0[1], q0, false); q0 = __builtin_amdgcn_cvt_pk_fp8_f32(v[2] * g0[2], v[3] * g0[3], q0, true);
                    q1 = __builtin_amdgcn_cvt_pk_fp8_f32(v[4] * g1[0], v[5] * g1[1], q1, false); q1 = __builtin_amdgcn_cvt_pk_fp8_f32(v[6] * g1[2], v[7] * g1[3], q1, true);
                    q8[2 * bj] = q0; q8[2 * bj + 1] = q1; }
                u32x4 w8; w8.x = (unsigned)q8[0]; w8.y = (unsigned)q8[1]; w8.z = (unsigned)q8[2]; w8.w = (unsigned)q8[3]; *(u32x4*)(X1q + off) = w8; }
    }
};
struct EpiGU {
    static constexpr bool PERM = true, PERM16 = false; static constexpr int NSTORE = 0;
    unsigned char* ACT; const PG8_LAS unsigned char* utab;
    __device__ __forceinline__ void operator()(const f32x4 (&acc)[2][2][4][2], const Unit& u, int ui, int wr, int wc, int fr, int fq) const {
        const PG8_LAS unsigned char* tb = utab + (ui & 1) * UT_BYTES;
        const PG8_LAS float* rsl = (const PG8_LAS float*)(tb + UT_ROWA); const PG8_LAS float* bl = (const PG8_LAS float*)(tb + UT_BIAS);
        const int rl0 = wr * 64 + fr, cl = wc * 32 + 8 * fq, colt = u.pn * HALF + cl;
        f32x4 bgv[2], buv[2];
#pragma unroll
        for (int n = 0; n < 2; ++n) { bgv[n] = *(const PG8_LAS f32x4*)(bl + cl + 4 * n); buv[n] = *(const PG8_LAS f32x4*)(bl + HALF + cl + 4 * n); }
#pragma unroll
        for (int ai = 0; ai < 2; ++ai)
#pragma unroll
            for (int m = 0; m < 4; ++m) { const int rl = rl0 + ai * HALF + m * 16; const float rs = rsl[rl] * (1.0f / 512.0f);
                float a[8];
#pragma unroll
                for (int n = 0; n < 2; ++n)
#pragma unroll
                    for (int j = 0; j < 4; j += 2) {
                        typedef float f2 __attribute__((ext_vector_type(2)));
                        const f2 rs2 = {rs, rs};
                        f2 g = (f2){acc[ai][0][m][n][j], acc[ai][0][m][n][j + 1]} * rs2 + (f2){bgv[n][j], bgv[n][j + 1]};
                        f2 l = (f2){acc[ai][1][m][n][j], acc[ai][1][m][n][j + 1]} * rs2 + (f2){buv[n][j], buv[n][j + 1]};
                        g.x = fminf(g.x, 7.0f); g.y = fminf(g.y, 7.0f); l.x = fminf(fmaxf(l.x, -7.0f), 7.0f); l.y = fminf(fmaxf(l.y, -7.0f), 7.0f);
                        const f2 t = g * (f2){-1.702f * LOG2E, -1.702f * LOG2E};
                        f2 e; e.x = __builtin_amdgcn_exp2f(t.x); e.y = __builtin_amdgcn_exp2f(t.y);
                        const f2 d = e + (f2){1.0f, 1.0f};
                        f2 sg; sg.x = __builtin_amdgcn_rcpf(d.x); sg.y = __builtin_amdgcn_rcpf(d.y);
                        const f2 r = (g * sg) * (l + (f2){1.0f, 1.0f});
                        a[n * 4 + j] = r.x; a[n * 4 + j + 1] = r.y; }
                int q0 = 0, q1 = 0; q0 = __builtin_amdgcn_cvt_pk_fp8_f32(a[0], a[1], q0, false); q0 = __builtin_amdgcn_cvt_pk_fp8_f32(a[2], a[3], q0, true);
                q1 = __builtin_amdgcn_cvt_pk_fp8_f32(a[4], a[5], q1, false); q1 = __builtin_amdgcn_cvt_pk_fp8_f32(a[6], a[7], q1, true);
                u32x2 w; w.x = (unsigned)q0; w.y = (unsigned)q1;
                *(u32x2*)(ACT + (size_t)(u.pm * BM + rl) * DEXP + colt) = w; }
    }
};
struct EpiDown {
    static constexpr bool PERM = true, PERM16 = true; static constexpr int NSTORE = 0;
    unsigned char* Y; const PG8_LAS unsigned char* utab;
    __device__ __forceinline__ void operator()(const f32x4 (&acc)[2][2][4][2], const Unit& u, int ui, int wr, int wc, int fr, int fq) const {
        const PG8_LAS unsigned char* tb = utab + (ui & 1) * UT_BYTES;
        const PG8_LAS float* gl = (const PG8_LAS float*)(tb + UT_ROWA); const PG8_LAS int* dl = (const PG8_LAS int*)(tb + UT_ROWB); const PG8_LAS float* bl = (const PG8_LAS float*)(tb + UT_BIAS);
        const int rl0 = wr * 64 + fr, cl = wc * 64 + 16 * fq, colt = u.pn * BM + cl;
        f32x4 bv[2][2];
#pragma unroll
        for (int bj = 0; bj < 2; ++bj)
#pragma unroll
            for (int n = 0; n < 2; ++n) bv[bj][n] = *(const PG8_LAS f32x4*)(bl + cl + 8 * bj + 4 * n);
#pragma unroll
        for (int ai = 0; ai < 2; ++ai)
#pragma unroll
            for (int m = 0; m < 4; ++m) { const int rl = rl0 + ai * HALF + m * 16;
                if (rl < u.nv) { const float gt = gl[rl] * 8.0f; const int dst = dl[rl];
                    __attribute__((address_space(1))) unsigned char* rowp = (__attribute__((address_space(1))) unsigned char*)Y + (size_t)dst * DM + colt;
                    int q8[4];
#pragma unroll
                    for (int bj = 0; bj < 2; ++bj) { const f32x4 v0 = (acc[ai][bj][m][0] * (1.0f / 512.0f) + bv[bj][0]) * gt, v1 = (acc[ai][bj][m][1] * (1.0f / 512.0f) + bv[bj][1]) * gt;
                        int q0 = 0, q1 = 0; q0 = __builtin_amdgcn_cvt_pk_fp8_f32(v0[0], v0[1], q0, false); q0 = __builtin_amdgcn_cvt_pk_fp8_f32(v0[2], v0[3], q0, true);
                        q1 = __builtin_amdgcn_cvt_pk_fp8_f32(v1[0], v1[1], q1, false); q1 = __builtin_amdgcn_cvt_pk_fp8_f32(v1[2], v1[3], q1, true);
                        q8[2 * bj] = q0; q8[2 * bj + 1] = q1; }
                    u32x4 w; w.x = (unsigned)q8[0]; w.y = (unsigned)q8[1]; w.z = (unsigned)q8[2]; w.w = (unsigned)q8[3];
                    *(__attribute__((address_space(1))) u32x4*)rowp = w; } }
    }
};

typedef int v8i __attribute__((ext_vector_type(8)));
typedef int v4i __attribute__((ext_vector_type(4)));
template <class Epi, class Sched, bool FP8 = false, int KR = 1, int EREP = 1>
__device__ __forceinline__ void gemm_phase(PG8_LAS unsigned char* lds, const void* Abase, const int K, const Sched& S, const Epi& E, const int wid_in) {
    unsigned z_ = 0u; asm volatile("" : "+s"(z_));
    int tid = wid_in * 64 + (int)__builtin_amdgcn_mbcnt_hi(~0u, __builtin_amdgcn_mbcnt_lo(~0u, z_)); asm volatile("" : "+v"(tid));
    const int wid = wid_in, lane = tid & 63, wr = wid >> 2, wc = wid & 3, fr = lane & 15, fq = lane >> 4;
    const int nt = K / BK;
    unsigned voffA[2], voffB[2];
#pragma unroll
    for (int i = 0; i < 2; ++i) { int R, C; stage_rc(tid * 16 + i * 8192, R, C); const int Rp = Epi::PERM ? ((R & ~31) + perm32(R & 31)) : R;
        const int Rb = Epi::PERM16 ? (2 * (Rp & ~7) + (Rp & 7)) : Rp;
        voffA[i] = (unsigned)(R * K + C) * 2u; voffB[i] = (unsigned)(Rb * (K + Sched::BPAD) + C) * 2u; }
    const size_t kstep = (size_t)(BK * 2);
    const size_t hstep = (size_t)HALF * K * 2;
    const size_t bhstep = Epi::PERM16 ? (size_t)8 * (K + Sched::BPAD) * 2 : (size_t)HALF * (K + Sched::BPAD) * 2;
    const unsigned ldsw = (unsigned)wid * 1024u;
    const int aoff0 = lds_chunk(wr * 64 + fr, fq), boff0 = lds_chunk(wc * 32 + fr, fq) + 4 * HTB;
#define PG8_KH1(off0, var) unsigned var = (unsigned)(off0) ^ 64u; asm volatile("" : "+v"(var))
#define PG8_SA(b, h) (((b) * 2 + (h)) * HTB)
#define PG8_SB(b, h) ((4 + (b) * 2 + (h)) * HTB)
#define PG8_SBR(b, h) (((b) * 2 + (h)) * HTB)
#define PG8_STAGE(bufoff, gbase, voff) do { _Pragma("unroll") for (int _i = 0; _i < 2; ++_i) { unsigned _o = (voff)[_i]; asm volatile("" : "+v"(_o));     \
        __builtin_amdgcn_global_load_lds((const unsigned*)((const char*)(gbase) + _o), (PG8_LAS unsigned*)(lds + (bufoff) + ldsw + _i * 8192), 16, 0, 0); } } while (0)
#define PG8_LD8(a0, a1) __builtin_shufflevector(*(const PG8_LAS v4i*)(a0), *(const PG8_LAS v4i*)(a1), 0, 1, 2, 3, 4, 5, 6, 7)
#define PG8_LDA(dst, b, h) do { PG8_KH1(aoff0, aoff1_); if constexpr (FP8) { _Pragma("unroll") for (int m = 0; m < 4; ++m) dst##8[m] = PG8_LD8(lds + PG8_SA(b, h) + aoff0 + m * 2048, lds + PG8_SA(b, h) + aoff1_ + m * 2048); } \
        else { _Pragma("unroll") for (int m = 0; m < 4; ++m) { dst[m][0] = *(const PG8_LAS bf16x8*)(lds + PG8_SA(b, h) + aoff0 + m * 2048); dst[m][1] = *(const PG8_LAS bf16x8*)(lds + PG8_SA(b, h) + aoff1_ + m * 2048); } } } while (0)
#define PG8_LDB(dst, b, h) do { PG8_KH1(boff0, boff1_); if constexpr (FP8) { _Pragma("unroll") for (int n = 0; n < 2; ++n) dst##8[n] = PG8_LD8(lds + PG8_SBR(b, h) + boff0 + n * 2048, lds + PG8_SBR(b, h) + boff1_ + n * 2048); } \
        else { _Pragma("unroll") for (int n = 0; n < 2; ++n) { dst[n][0] = *(const PG8_LAS bf16x8*)(lds + PG8_SBR(b, h) + boff0 + n * 2048); dst[n][1] = *(const PG8_LAS bf16x8*)(lds + PG8_SBR(b, h) + boff1_ + n * 2048); } } } while (0)
#define PG8_MMA(ai, bj, At, Bt) do { __builtin_amdgcn_s_setprio(1); \
        if constexpr (FP8) { _Pragma("unroll") for (int m = 0; m < 4; ++m) _Pragma("unroll") for (int n = 0; n < 2; ++n) \
            acc[ai][bj][m][n] = __builtin_amdgcn_mfma_scale_f32_16x16x128_f8f6f4(Bt##8[n], At##8[m], acc[ai][bj][m][n], 0, 0, 0, 0x7f7f7f7f, 0, 0x7f7f7f7f); } \
        else { _Pragma("unroll") for (int m = 0; m < 4; ++m) _Pragma("unroll") for (int n = 0; n < 2; ++n) _Pragma("unroll") for (int k = 0; k < 2; ++k) \
            acc[ai][bj][m][n] = __builtin_amdgcn_mfma_f32_16x16x32_bf16(Bt[n][k], At[m][k], acc[ai][bj][m][n], 0, 0, 0); } \
        __builtin_amdgcn_s_setprio(0); } while (0)
#define PG8_WAIT_V(n) asm volatile("s_waitcnt vmcnt(" #n ")" ::: "memory")
#define PG8_WAIT_L(n) asm volatile("s_waitcnt lgkmcnt(" #n ")" ::: "memory")
#define PG8_WAIT_VF(t_) asm volatile("s_cmp_lg_u32 %0, 0\n\ts_cbranch_scc1 1f\n\ts_waitcnt vmcnt(%1)\n\ts_branch 2f\n1:\n\ts_waitcnt vmcnt(8)\n2:" :: "s"(t_), "n"(8 + Epi::NSTORE) : "memory", "scc")
#define PG8_BAR __builtin_amdgcn_s_barrier()
#define PG8_SCHED __builtin_amdgcn_sched_barrier(0)
    Unit cur, nxt; int ui = 0;
    if (!S.next(0, cur)) return;
    f32x4 acc[2][2][4][2];
#pragma unroll
    for (int a = 0; a < 2; ++a)
#pragma unroll
        for (int b = 0; b < 2; ++b)
#pragma unroll
            for (int m = 0; m < 4; ++m)
#pragma unroll
                for (int n = 0; n < 2; ++n) acc[a][b][m][n] = (f32x4){0.f, 0.f, 0.f, 0.f};
    bf16x8 At[4][2], B0[2][2], B1[2][2];
    v8i At8[4], B08[2], B18[2];
    unsigned ca[2][2];
    S.aoffs(cur, tid, ca);
    const char* const Ab = (const char*)Abase;
    const char* cA = Ab + S.abase(cur);
    const char* cB = S.bbase(cur);
#define PG8_STAGE_A(bufoff, kb, h, nx) do { if constexpr (Sched::GATHER) { PG8_STAGE(bufoff, Ab + (kb), ca[h]); } \
        else PG8_STAGE(bufoff, ((nx) ? nA : cA) + (kb) + (h) * hstep, voffA); } while (0)
    const char* nA = cA;
    PG8_STAGE(PG8_SB(0, 0), cB, voffB); PG8_STAGE(PG8_SB(0, 1), cB + bhstep, voffB); PG8_STAGE_A(PG8_SA(0, 0), 0, 0, false); PG8_STAGE_A(PG8_SA(0, 1), 0, 1, false);
    if (wr == 1) PG8_BAR;
    PG8_WAIT_V(2); PG8_BAR;
    PG8_STAGE(PG8_SB(1, 0), cB + kstep, voffB); PG8_STAGE_A(PG8_SA(1, 0), kstep, 0, false); PG8_STAGE(PG8_SB(1, 1), cB + bhstep + kstep, voffB);
    PG8_STAGE_A(PG8_SA(1, 1), kstep, 1, false); PG8_WAIT_V(0);
    PG8_BAR;
    for (;;) {
        const bool has_next = S.next(ui + 1, nxt);
        S.unit_begin(cur, nxt, has_next, ui, wid, lane);
        nA = has_next ? Ab + S.abase(nxt) : cA;
        const char* nB = has_next ? S.bbase(nxt) : cB;
#pragma unroll 1
        for (int t = 0; t < nt * KR; t += 2) {
            const bool last = (t == nt * KR - 2);
            const int tw2 = (KR > 1) ? ((t + 2) & (nt - 1)) : (t + 2);
            const size_t k1 = (size_t)((KR > 1) ? ((t + 1) & (nt - 1)) : (t + 1)) * kstep; const size_t k2 = last ? (size_t)0 : (size_t)tw2 * kstep, k3 = k2 + kstep;
            const char* b2 = last ? nB : cB + (size_t)tw2 * kstep; const char* b3 = b2 + kstep;
            PG8_LDB(B0, 0, 0); PG8_LDB(B1, 0, 1); PG8_SCHED; PG8_LDA(At, 0, 0); if (t != 0) PG8_STAGE_A(PG8_SA(1, 1), k1, 1, false);
            PG8_WAIT_VF(t); PG8_WAIT_L(0); PG8_BAR; PG8_MMA(0, 0, At, B0); PG8_MMA(0, 1, At, B1);
            if (Sched::GATHER && last && has_next) { asm volatile("" ::: "memory"); S.aoffs_lds(nxt, wid, ui, ca); }
            PG8_BAR; PG8_SCHED;
            PG8_LDA(At, 0, 1); PG8_STAGE(PG8_SB(0, 0), b2, voffB); PG8_STAGE(PG8_SB(0, 1), b2 + bhstep, voffB); PG8_STAGE_A(PG8_SA(0, 0), k2, 0, last);
            PG8_WAIT_VF(t); PG8_WAIT_L(0); PG8_BAR; PG8_MMA(1, 0, At, B0); PG8_MMA(1, 1, At, B1); PG8_BAR; PG8_SCHED;
            PG8_LDB(B0, 1, 0); PG8_LDB(B1, 1, 1); PG8_SCHED; PG8_LDA(At, 1, 0); PG8_STAGE_A(PG8_SA(0, 1), k2, 1, last);
            PG8_WAIT_VF(t); PG8_WAIT_L(0); PG8_BAR; PG8_MMA(0, 0, At, B0); PG8_MMA(0, 1, At, B1); PG8_BAR; PG8_SCHED;
            PG8_LDA(At, 1, 1); PG8_STAGE(PG8_SB(1, 0), b3, voffB); PG8_STAGE(PG8_SB(1, 1), b3 + bhstep, voffB); PG8_STAGE_A(PG8_SA(1, 0), k3, 0, last);
            PG8_WAIT_V(8); PG8_WAIT_L(0); PG8_BAR; PG8_MMA(1, 0, At, B0); PG8_MMA(1, 1, At, B1); PG8_BAR; PG8_SCHED;
        }
        PG8_STAGE_A(PG8_SA(1, 1), kstep, 1, true);
        if (wr == 0) PG8_BAR;
        { const int l2 = lane_now();
          E(acc, cur, ui, wr, wc, l2 & 15, l2 >> 4);
          if constexpr (EREP > 1) { asm volatile("" ::: "memory"); const int l3 = lane_now(); E(acc, cur, ui, wr, wc, l3 & 15, l3 >> 4); } }
        if (!has_next) break;
#pragma unroll
        for (int a = 0; a < 2; ++a)
#pragma unroll
            for (int b = 0; b < 2; ++b)
#pragma unroll
                for (int m = 0; m < 4; ++m)
#pragma unroll
                    for (int n = 0; n < 2; ++n) acc[a][b][m][n] = (f32x4){0.f, 0.f, 0.f, 0.f};
        cur = nxt; cB = nB; cA = nA; ++ui;
        if (wr == 1) PG8_BAR;
    }
    PG8_WAIT_V(0);
    PG8_BAR;
#undef PG8_SA
#undef PG8_SB
#undef PG8_SBR
#undef PG8_STAGE
#undef PG8_STAGE_A
#undef PG8_KH1
#undef PG8_LDA
#undef PG8_LDB
#undef PG8_MMA
#undef PG8_WAIT_V
#undef PG8_WAIT_L
#undef PG8_WAIT_VF
#undef PG8_BAR
#undef PG8_SCHED
}
}

typedef unsigned short bf16;
typedef unsigned v4u __attribute__((ext_vector_type(4)));
typedef unsigned v2u __attribute__((ext_vector_type(2)));
typedef float f32x4 __attribute__((ext_vector_type(4)));
typedef float f32x16 __attribute__((ext_vector_type(16)));
typedef short bf16x8 __attribute__((ext_vector_type(8)));
typedef short s16x4 __attribute__((ext_vector_type(4)));
typedef GAS unsigned gu32;
#define RLX_AGENT __ATOMIC_RELAXED, __HIP_MEMORY_SCOPE_AGENT
#define LDS_WAIT() asm volatile("s_waitcnt lgkmcnt(0)" ::: "memory")
#define VM_WAIT() asm volatile("s_waitcnt vmcnt(0)" ::: "memory")
__device__ __forceinline__ unsigned f2bf(float f) { unsigned u = __builtin_bit_cast(unsigned, f); return (u + 0x7fffu + ((u >> 16) & 1u)) >> 16; }
__device__ __forceinline__ unsigned pk2(float lo, float hi) { return f2bf(lo) | (f2bf(hi) << 16); }
__device__ __forceinline__ float bflo(unsigned u) { return __builtin_bit_cast(float, u << 16); }
__device__ __forceinline__ float bfhi(unsigned u) { return __builtin_bit_cast(float, u & 0xffff0000u); }

#define XB_TMO      128
#define XB_XCNT(j)  (256  + 64 * (j))
#define XB_XSUB(j)  (1280 + 64 * (j))
#define XB_XGEN(j)  (2304 + 64 * (j))
#define XB_TOP      3328
#define XB_TOPGEN   3392
#define XCD_BAR_WORDS 3456
#define XB_SPIN_CAP (1u << 18)
__device__ __forceinline__ unsigned xb_ld(unsigned* p)              { return __hip_atomic_load(p, __ATOMIC_RELAXED, __HIP_MEMORY_SCOPE_AGENT); }
__device__ __forceinline__ unsigned xb_add(unsigned* p, unsigned v) { return __hip_atomic_fetch_add(p, v, __ATOMIC_RELAXED, __HIP_MEMORY_SCOPE_AGENT); }
__device__ __forceinline__ unsigned xb_xcc_id() { return (unsigned)__builtin_amdgcn_s_getreg((3 << 11) | 20) & 0xFu; }
#define XB_SPIN(cond, bar) do { unsigned _sp = 0; while (cond) { __builtin_amdgcn_s_sleep(1); \
    if ((++_sp & 255u) == 0u) { if (xb_ld(&(bar)[XB_TMO])) break; if (_sp > XB_SPIN_CAP) { atomicAdd(&(bar)[XB_TMO], 1u); break; } } } } while (0)
struct XcdBarrier { unsigned* bar; unsigned x; volatile LAS unsigned* st; };
__device__ __forceinline__ XcdBarrier xcd_barrier_post(unsigned* bar, volatile LAS unsigned* st) {
    XcdBarrier b; b.bar = bar; b.x = xb_xcc_id(); b.st = st;
    if (threadIdx.x == 0) (void)xb_add(&bar[XB_XCNT(b.x)], 1u);
    return b;
}
__device__ __forceinline__ void xcd_barrier_complete(unsigned* bar, unsigned x, unsigned& nloc, unsigned& nx) {
    const unsigned G = gridDim.x * gridDim.y * gridDim.z;
    unsigned sum, cnt, mine, sp = 0u;
    for (;;) {
        sum = 0u; cnt = 0u; mine = 0u;
#pragma unroll
        for (unsigned j = 0; j < 16; ++j) { const unsigned c = xb_ld(&bar[XB_XCNT(j)]); sum += c; cnt += (c > 0u) ? 1u : 0u; mine = (j == x) ? c : mine; }
        if (sum == G) break;
        __builtin_amdgcn_s_sleep(1);
        if ((++sp & 255u) == 0u) { if (xb_ld(&bar[XB_TMO])) break; if (sp > XB_SPIN_CAP) { atomicAdd(&bar[XB_TMO], 1u); break; } }
    }
    nloc = mine > 0u ? mine : 1u; nx = cnt > 0u ? cnt : 1u;
}
__device__ __forceinline__ void xcd_barrier(const XcdBarrier& b, const int wid) {
    asm volatile("s_waitcnt vmcnt(0)" ::: "memory");
    __syncthreads();
    unsigned zb_ = 0u; asm volatile("" : "+s"(zb_));
    if (wid == 0 && __builtin_amdgcn_mbcnt_hi(~0u, __builtin_amdgcn_mbcnt_lo(~0u, zb_)) == 0u) {
        unsigned* bar = b.bar;
        __builtin_amdgcn_s_waitcnt(0);
        unsigned nloc = b.st[0], nx = b.st[1];
        if (nloc == 0u) { xcd_barrier_complete(bar, b.x, nloc, nx); b.st[0] = nloc; b.st[1] = nx; }
        const unsigned old = xb_add(&bar[XB_XSUB(b.x)], 1u);
        const unsigned gen = old / nloc;
        if (old + 1u == (gen + 1u) * nloc) {
            __builtin_amdgcn_fence(__ATOMIC_RELEASE, "agent");
            asm volatile("s_waitcnt vmcnt(0)" ::: "memory");
            const unsigned og = xb_add(&bar[XB_TOP], 1u);
            const unsigned tg = og / nx;
            if (og + 1u == (tg + 1u) * nx) xb_add(&bar[XB_TOPGEN], 1u);
            else XB_SPIN(xb_ld(&bar[XB_TOPGEN]) == tg, bar);
            __builtin_amdgcn_fence(__ATOMIC_ACQUIRE, "agent");
            xb_add(&bar[XB_XGEN(b.x)], 1u);
            asm volatile("s_waitcnt vmcnt(0)" ::: "memory");
        } else {
            XB_SPIN(xb_ld(&bar[XB_XGEN(b.x)]) == gen, bar);
            __builtin_amdgcn_fence(__ATOMIC_ACQUIRE, "agent");
            asm volatile("s_waitcnt vmcnt(0)" ::: "memory");
        }
    }
    __syncthreads();
}

constexpr size_t MiB = 1u << 20;
constexpr size_t WS_CTL = 0, CTL_ZERO_BYTES = 1 * MiB;
constexpr int WPITCH = DM + 64;
constexpr size_t WS_WQKV = 972 * MiB;
constexpr size_t WS_WO = 980 * MiB;
constexpr size_t WS_WD = 9 * MiB;
constexpr size_t WS_TOK = 41 * MiB;
constexpr size_t WS_GATE = 49 * MiB;
constexpr size_t WS_RS = 57 * MiB;
constexpr size_t WS_DST = 65 * MiB;
constexpr size_t WS_X1B = 73 * MiB;
constexpr size_t WS_X1Q = 201 * MiB;
constexpr size_t WS_BIG = 265 * MiB;
constexpr size_t WS_XN = WS_BIG, WS_QKV = WS_BIG + 128 * MiB, WS_ACT = WS_BIG;
constexpr size_t WS_Y1 = WS_BIG + 264 * MiB;
constexpr size_t WS_WGU = WS_BIG + 512 * MiB;
constexpr size_t WS_O = WS_WGU + 64 * MiB;
constexpr size_t WS_RMS1 = WS_O + 128 * MiB;
constexpr size_t WS_END = 984 * MiB;
static_assert(WS_QKV + (size_t)NTOK * NQKV * 2 <= WS_WGU && WS_ACT + (size_t)NSLOT * DEXP <= WS_Y1 && WS_Y1 + (size_t)NTOK * 2 * DM * 2 <= WS_END && WS_END <= 1024 * MiB, "d_ws map");
constexpr int CW_CNT = 64;
constexpr int CW_BAR = 4096;

constexpr int RING_BYTES = 131072;
constexpr int MISC_OFF = RING_BYTES + 320;
constexpr int HIST_OFF = RING_BYTES + 512, BASE_OFF = RING_BYTES + 640, CNTL_OFF = RING_BYTES + 768, FIRST_OFF = RING_BYTES + 896, RBTAB_OFF = RING_BYTES + 1152;
constexpr int UTAB_OFF = RING_BYTES + 6144;
constexpr int XPOSE_OFF = 147456;
constexpr int LDS_BYTES = 163840;
static_assert(RBTAB_OFF + MAXRB * 4 <= UTAB_OFF && UTAB_OFF + 2 * 4096 <= XPOSE_OFF && XPOSE_OFF + 8 * 2048 <= LDS_BYTES, "LDS map");

struct Args { const float* in[17]; float* out; unsigned char* ws; };

__device__ __forceinline__ float wave_sum(float v) {
#pragma unroll
    for (int o = 1; o < 64; o <<= 1) v += __shfl_xor(v, o);
    return v;
}
__device__ __forceinline__ int crow(int r, int hi) { return (r & 3) + 8 * (r >> 2) + 4 * hi; }

template <bool SIG = false>
__device__ __forceinline__ void p0_item(const float* W, int N, bf16* WTrow  , int K, const float* gk, float sn, int k0, int n0, int lane) {
    const GAS f32x4* src = (const GAS f32x4*)(W + (size_t)k0 * N + n0) + lane;
    const int n4 = N >> 2;
#pragma unroll 2
    for (int g = 0; g < 8; ++g) {
        f32x4 v[8];
#pragma unroll
        for (int i = 0; i < 8; ++i) v[i] = src[(size_t)(8 * g + i) * n4];
#pragma unroll
        for (int i = 0; i < 8; ++i) { const float sc = gk ? gk[k0 + 8 * g + i] * sn : sn; v[i] = v[i] * sc; }
#pragma unroll
        for (int j = 0; j < 4; ++j) { v4u o; o.x = pk2(v[0][j], v[1][j]); o.y = pk2(v[2][j], v[3][j]); o.z = pk2(v[4][j], v[5][j]); o.w = pk2(v[6][j], v[7][j]);
            if (SIG) { v2u lo; lo.x = o.x; lo.y = o.y; v2u hh; hh.x = o.z; hh.y = o.w;
                *(GAS v2u*)(WTrow + (size_t)j * K + k0 + 4 * g) = lo; *(GAS v2u*)(WTrow + (size_t)j * K + k0 + 32 + 4 * g) = hh; }
            else *(GAS v4u*)(WTrow + (size_t)j * K + k0 + 8 * g) = o; }
    }
}
__device__ __forceinline__ void p0_item8(const float* W, int N, unsigned char* WTrow  , int K, const float* gk, float sn, int k0, int n0, int lane) {
    const GAS f32x4* src = (const GAS f32x4*)(W + (size_t)k0 * N + n0) + lane;
    const int n4 = N >> 2;
#pragma unroll 1
    for (int g = 0; g < 4; ++g) {
        f32x4 v[16];
#pragma unroll
        for (int i = 0; i < 16; ++i) v[i] = src[(size_t)(16 * g + i) * n4];
#pragma unroll
        for (int i = 0; i < 16; ++i) { const float sc = gk ? gk[k0 + 16 * g + i] * sn : sn; v[i] = v[i] * sc; }
#pragma unroll
        for (int j = 0; j < 4; ++j) { v4u o;
#pragma unroll
            for (int q = 0; q < 4; ++q) { int w = 0; w = __builtin_amdgcn_cvt_pk_fp8_f32(v[4 * q][j], v[4 * q + 1][j], w, false); w = __builtin_amdgcn_cvt_pk_fp8_f32(v[4 * q + 2][j], v[4 * q + 3][j], w, true); o[q] = (unsigned)w; }
            *(GAS v4u*)(WTrow + (size_t)j * K + k0 + 16 * g) = o; }
    }
}
__device__ __forceinline__ void p0_tile8(const float* W, int N, unsigned char* WT0  , int K, const float* gk, float sn, int k0, int n0, LAS unsigned char* scr, int lane) {
    lane = pg8::lane_now();
    const int ks = lane >> 4, n4 = lane & 15;
    const GAS f32x4* src = (const GAS f32x4*)(W + (size_t)(k0 + 4 * ks) * N + n0) + n4;
    const int n4s = N >> 2;
#pragma unroll 1
    for (int q0 = 0; q0 < 8; q0 += 4) {
        f32x4 v[4][4];
#pragma unroll
        for (int qq = 0; qq < 4; ++qq)
#pragma unroll
            for (int i = 0; i < 4; ++i) v[qq][i] = src[(size_t)(16 * (q0 + qq) + i) * n4s];
#pragma unroll
        for (int qq = 0; qq < 4; ++qq) { const int q = q0 + qq;
#pragma unroll
            for (int i = 0; i < 4; ++i) { const float sc = gk ? gk[k0 + 16 * q + 4 * ks + i] * sn : sn; v[qq][i] = v[qq][i] * sc; }
#pragma unroll
            for (int j = 0; j < 4; ++j) { int w = 0; w = __builtin_amdgcn_cvt_pk_fp8_f32(v[qq][0][j], v[qq][1][j], w, false); w = __builtin_amdgcn_cvt_pk_fp8_f32(v[qq][2][j], v[qq][3][j], w, true);
                const int n = 4 * n4 + j; *(LAS int*)(scr + n * 128 + ((q ^ ((n >> 2) & 7)) << 4) + 4 * ks) = w; } }
    }
#pragma unroll
    for (int i = 0; i < 8; ++i) { const int n = 8 * i + (lane >> 3), c = lane & 7;
        const v4u o = *(const LAS v4u*)(scr + n * 128 + ((c ^ ((n >> 2) & 7)) << 4));
        *(GAS v4u*)(WT0 + (size_t)n * K + k0 + 16 * c) = o; }
}
__device__ __forceinline__ void p0_load2(const float* x, int m, int lane, f32x4 (&v)[2][4]) {
    const GAS f32x4* xr = (const GAS f32x4*)(x + (size_t)m * DM) + lane;
#pragma unroll
    for (int q = 0; q < 2; ++q)
#pragma unroll
        for (int j = 0; j < 4; ++j) v[q][j] = xr[q * 256 + 64 * j];
}
__device__ __forceinline__ void p0_proc2(const f32x4 (&v)[2][4], bf16* XN, float* RMS1, int m, int lane) {
    float s2[2] = {0.f, 0.f};
#pragma unroll
    for (int q = 0; q < 2; ++q) {
#pragma unroll
        for (int j = 0; j < 4; ++j) s2[q] += (v[q][j].x * v[q][j].x + v[q][j].y * v[q][j].y) + (v[q][j].z * v[q][j].z + v[q][j].w * v[q][j].w);
        const float ms = wave_sum(s2[q]) * (1.0f / DM) + RMS_EPS, rstd = 1.0f / sqrtf(ms);
        if (lane == 0) RMS1[m + q] = sqrtf(ms);
        GAS unsigned long long* o8 = (GAS unsigned long long*)(XN + (size_t)(m + q) * DM) + lane;
#pragma unroll
        for (int j = 0; j < 4; ++j) o8[64 * j] = (unsigned long long)pk2(v[q][j].x * rstd, v[q][j].y * rstd) | ((unsigned long long)pk2(v[q][j].z * rstd, v[q][j].w * rstd) << 32);
    }
}
__device__ __forceinline__ void p0_rows(const float* x, bf16* XN, float* RMS1, int m0, int m1, int lane) {
    f32x4 va[2][4], vb[2][4];
    p0_load2(x, m0, lane, va);
#pragma unroll 1
    for (int m = m0; m < m1; m += 4) {
        const bool hb = m + 2 < m1;
        if (hb) p0_load2(x, m + 2, lane, vb);
        p0_proc2(va, XN, RMS1, m, lane);
        if (hb) { if (m + 4 < m1) p0_load2(x, m + 4, lane, va);
            p0_proc2(vb, XN, RMS1, m + 2, lane); }
    }
}

template <int B> __device__ __forceinline__ bf16x8 pack8(const f32x16& p) {
    v4u w; w.x = pg8::cvt_pk_bf16(p[B + 0], p[B + 1]); w.y = pg8::cvt_pk_bf16(p[B + 2], p[B + 3]); w.z = pg8::cvt_pk_bf16(p[B + 4], p[B + 5]); w.w = pg8::cvt_pk_bf16(p[B + 6], p[B + 7]);
    return __builtin_bit_cast(bf16x8, w);
}
typedef short v4i16_t __attribute__((ext_vector_type(4)));
__device__ __forceinline__ s16x4 vtr(const LAS unsigned char* p) { return __builtin_bit_cast(s16x4, __builtin_amdgcn_ds_read_tr16_b64_v4i16((LAS v4i16_t*)p)); }

struct KVt { v4u k[4]; v4u v[4]; };
constexpr int KIMG = 32 * 144, VIMG = 4096, KVIMG = KIMG + VIMG;
__device__ __forceinline__ void kv_put(LAS unsigned char* kst, LAS unsigned char* vst, const KVt& t, int lane) {
#pragma unroll
    for (int i = 0; i < 4; ++i) { *(LAS v4u*)(kst + (8 * i + (lane >> 3)) * 144 + (lane & 7) * 16) = t.k[i];
        *(LAS v4u*)(vst + ((lane & 7) >> 2) * 2048 + (8 * i + (lane >> 3)) * 64 + (lane & 3) * 16) = t.v[i]; }
}
__device__ __forceinline__ f32x16 qk_mma(const LAS unsigned char* kst, const bf16x8 (&qf)[4], int lane) {
    const LAS unsigned char* kp = kst + (lane & 31) * 144 + (lane >> 5) * 16;
    bf16x8 kf[4];
#pragma unroll
    for (int d0 = 0; d0 < 4; ++d0) kf[d0] = *(const LAS bf16x8*)(kp + d0 * 32);
    f32x16 p = {};
#pragma unroll
    for (int d0 = 0; d0 < 4; ++d0) p = __builtin_amdgcn_mfma_f32_32x32x16_bf16(kf[d0], qf[d0], p, 0, 0, 0);
    return p;
}
__device__ __forceinline__ void v_frags(bf16x8 (&vf)[2][2], const LAS unsigned char* vst, int lane) {
    const int hi = lane >> 5, blk = (lane >> 4) & 1, qq = (lane & 15) >> 2, p = lane & 3;
    const LAS unsigned char* vb = vst + (4 * hi + qq) * 64 + blk * 32 + p * 8;
#pragma unroll
    for (int c = 0; c < 2; ++c)
#pragma unroll
        for (int ks = 0; ks < 2; ++ks) {
            const s16x4 lo = vtr(vb + c * 2048 + (16 * ks) * 64), hh = vtr(vb + c * 2048 + (16 * ks + 8) * 64);
            vf[c][ks] = (bf16x8){lo[0], lo[1], lo[2], lo[3], hh[0], hh[1], hh[2], hh[3]};
        }
}
__device__ __forceinline__ void pv_mma(f32x16 (&o)[2], const bf16x8 (&vf)[2][2], const bf16x8 (&pa)[2]) {
#pragma unroll
    for (int c = 0; c < 2; ++c)
#pragma unroll
        for (int ks = 0; ks < 2; ++ks) o[c] = __builtin_amdgcn_mfma_f32_32x32x16_bf16(vf[c][ks], pa[ks], o[c], 0, 0, 0);
}
__device__ __forceinline__ void pv_tile(f32x16 (&o)[2], const LAS unsigned char* vst, const bf16x8 (&pa)[2], int lane) {
    bf16x8 vf[2][2]; v_frags(vf, vst, lane); pv_mma(o, vf, pa);
}
__device__ __forceinline__ void xp32_store(LAS unsigned char* vst, const v4u (&w)[4], bf16* o0, size_t rstr, int lane) {
    const int r32 = lane & 31, hi = lane >> 5, rt = lane >> 3, ct = lane & 7;
#pragma unroll
    for (int i = 0; i < 4; ++i) *(LAS v4u*)(vst + r32 * 128 + (((4 * hi + i) ^ (r32 & 7)) << 4)) = w[i];
    __builtin_amdgcn_wave_barrier();
    v4u d[4];
#pragma unroll
    for (int j = 0; j < 4; ++j) d[j] = *(const LAS v4u*)(vst + (8 * j + rt) * 128 + ((ct ^ rt) << 4));
    __builtin_amdgcn_wave_barrier();
#pragma unroll
    for (int j = 0; j < 4; ++j) *(GAS v4u*)(o0 + (size_t)(8 * j + rt) * rstr + 8 * ct) = d[j];
}
__device__ __forceinline__ void xp32_load(v4u (&t)[4], const bf16* p0, size_t rstr, int lane) {
    const int rt = lane >> 3, ct = lane & 7;
#pragma unroll
    for (int j = 0; j < 4; ++j) t[j] = *(const GAS v4u*)(p0 + (size_t)(8 * j + rt) * rstr + 8 * ct);
}
__device__ __forceinline__ void xp32_unpack(LAS unsigned char* vst, const v4u (&t)[4], v4u (&w)[4], int lane) {
    const int r32 = lane & 31, hi = lane >> 5, rt = lane >> 3, ct = lane & 7;
#pragma unroll
    for (int j = 0; j < 4; ++j) *(LAS v4u*)(vst + (8 * j + rt) * 128 + ((ct ^ rt) << 4)) = t[j];
    __builtin_amdgcn_wave_barrier();
#pragma unroll
    for (int i = 0; i < 4; ++i) w[i] = *(const LAS v4u*)(vst + r32 * 128 + (((4 * hi + i) ^ (r32 & 7)) << 4));
    __builtin_amdgcn_wave_barrier();
}
__device__ __forceinline__ void attn_store(f32x16 (&o)[2], float inv, LAS float* xs  , LAS unsigned char* vst, bf16* o0  , size_t rstr, int wid, int lane) {
    const int r32 = lane & 31, hi = lane >> 5;
    float ss = 0.f;
#pragma unroll
    for (int c = 0; c < 2; ++c)
#pragma unroll
        for (int r = 0; r < 16; ++r) { o[c][r] *= inv; ss += o[c][r] * o[c][r]; }
    ss += __shfl_xor(ss, 32);
    if (hi == 0) xs[wid * 32 + r32] = ss;
    LDS_WAIT(); __builtin_amdgcn_s_barrier(); asm volatile("" ::: "memory");
    float tot = 0.f;
#pragma unroll
    for (int w = 0; w < 8; ++w) tot += xs[w * 32 + r32];
    const float rstd = 1.0f / sqrtf(tot * (1.0f / 512.0f) + RMS_EPS);
    v4u w4[4];
#pragma unroll
    for (int c = 0; c < 2; ++c)
#pragma unroll
        for (int gp = 0; gp < 2; ++gp)
#pragma unroll
            for (int t = 0; t < 4; ++t) w4[2 * c + gp][t] = pg8::cvt_pk_bf16(o[c][8 * gp + 2 * t] * rstd, o[c][8 * gp + 2 * t + 1] * rstd);
    xp32_store(vst, w4, o0, rstr, lane);
}

__global__ void __launch_bounds__(512, 2) hybrid_fwd(Args args) {
    extern __shared__ __attribute__((aligned(16))) unsigned char lds_raw[];
    LAS unsigned char* lds = (LAS unsigned char*)lds_raw;
    volatile LAS unsigned* MISC = (volatile LAS unsigned*)(lds + MISC_OFF);
    const int G = gridDim.x, bx = blockIdx.x;
    const int wid_s = __builtin_amdgcn_readfirstlane((int)threadIdx.x >> 6);
    const int vcu = (G % 8 == 0) ? (bx % 8) * (G / 8) + bx / 8 : bx;
#define ENV() const __attribute__((address_space(4))) Args* ap = (const __attribute__((address_space(4))) Args*)__builtin_amdgcn_kernarg_segment_ptr(); asm volatile("" : "+s"(ap)); \
    unsigned char* const ws = ap->ws; float* const out = ap->out; (void)out; \
    const int wid = wid_s; unsigned z_ = 0u; asm volatile("" : "+s"(z_)); int tid = wid_s * 64 + (int)__builtin_amdgcn_mbcnt_hi(~0u, __builtin_amdgcn_mbcnt_lo(~0u, z_)); asm volatile("" : "+v"(tid)); const int lane = tid & 63; (void)lane; (void)wid; \
    const int gw = vcu * 8 + wid, NGW = G * 8; (void)gw; (void)NGW
#define IN(i) (ap->in[i])
#define GRID_BAR() do { ENV(); XcdBarrier bar_; bar_.bar = (unsigned*)(ws + WS_CTL) + CW_BAR; bar_.x = xb_xcc_id(); bar_.st = (volatile LAS unsigned*)(lds + MISC_OFF) + 8; xcd_barrier(bar_, wid_s); } while (0)
    {
        ENV();
        for (int u = tid; u < (LDS_BYTES - RING_BYTES) / 4; u += 512) ((LAS unsigned*)(lds + RING_BYTES))[u] = 0u;
        __syncthreads();
        (void)xcd_barrier_post((unsigned*)(ws + WS_CTL) + CW_BAR, MISC + 8);
    }

#pragma unroll 1
    for (int rep = 0; rep < REP_P0; ++rep) {
        ENV();
        const float* x = IN(0); const float* g_attn = IN(1); const float* w_qkv = IN(2); const float* g_out_dil = IN(4); const float* g_out_sb = IN(5); const float* w_o = IN(6); const float* g_moe = IN(7);
        const float* w_gate = IN(10); const float* w_up = IN(12); const float* w_down = IN(14);
        bf16* Wqkv_t = (bf16*)(ws + WS_WQKV); bf16* Wo_t = (bf16*)(ws + WS_WO); unsigned char* Wd8 = ws + WS_WD; unsigned char* Wgu8 = ws + WS_WGU; bf16* XN = (bf16*)(ws + WS_XN);
        constexpr int I_QKV = 16 * 12, I_O = 16 * 4, NSMALL = I_QKV + I_O;
        for (int it = gw; it < NSMALL; it += NGW) {
            int r = it;
            if (r < I_QKV) { const int kb = r / 12, nb = r % 12, n0 = 256 * nb; const float sn = (n0 < 512 || (n0 >= 1536 && n0 < 2048)) ? QSCALE : 1.0f;
                p0_item(w_qkv, NQKV, Wqkv_t + (size_t)(n0 + 4 * lane) * WPITCH, WPITCH, g_attn, sn, 64 * kb, n0, lane); continue; }
            r -= I_QKV;
            { const int kb = r / 4, nb = r % 4, n0 = 256 * nb, k0 = 64 * kb;
                p0_item<true>(w_o, DM, Wo_t + (size_t)(n0 + 4 * lane) * WPITCH, WPITCH, (k0 < 512) ? g_out_dil : (g_out_sb - 512), 1.0f, k0, n0, lane); }
        }
        constexpr int NITEMS = NSMALL + 3 * 2048;
        if (NGW == 2048) { const int heavy = NITEMS - 3 * 2048;
            const int nrow = (gw < heavy) ? 18 : 34, m0 = (gw < heavy) ? gw * 18 : heavy * 18 + (gw - heavy) * 34;
            p0_rows(x, XN, (float*)(ws + WS_RMS1), m0, m0 + nrow, lane);
        } else { for (int m = 2 * gw; m < NTOK; m += 2 * NGW) p0_rows(x, XN, (float*)(ws + WS_RMS1), m, m + 2, lane); }
    }
    GRID_BAR();

#pragma unroll 1
    for (int rep = 0; rep < REP_P1; ++rep) {
        ENV();
        bf16* Wqkv_t = (bf16*)(ws + WS_WQKV); bf16* XN = (bf16*)(ws + WS_XN); bf16* QKV = (bf16*)(ws + WS_QKV);
        pg8::DenseOrder S; S.init(NTOK, NQKV, DM, G, bx, Wqkv_t); if (rep > 0) S.maxi = REP_P1_UNITS;
        pg8::EpiQKV E{QKV, NQKV, lds + XPOSE_OFF};
        pg8::gemm_phase<pg8::EpiQKV, pg8::DenseOrder, false, KREP_P1, EREP_P1>(lds, XN, DM, S, E, wid_s);
    }
    GRID_BAR();

    {
        ENV();
        const float* rel_bias = IN(3); bf16* QKV = (bf16*)(ws + WS_QKV); bf16* OB = (bf16*)(ws + WS_O);
        constexpr int SZ0 = 384, PL0 = 128, SZ1 = 192, PL1 = 32, SZ2 = 192, PL2 = 32;
        LAS unsigned char* vst = lds + wid * KVIMG;
        LAS unsigned char* kst = vst + VIMG;
        LAS float* xsb = (LAS float*)(lds + 8 * KVIMG);
        LAS float* tb0 = xsb + 512; LAS float* tb1 = tb0 + 8 * SZ0; LAS float* tb2 = tb1 + 8 * SZ1;
        const float* g_moe = IN(7); const float* w_gate = IN(10); const float* w_up = IN(12); const float* w_down = IN(14); unsigned char* Wd8 = ws + WS_WD; unsigned char* Wgu8 = ws + WS_WGU;
        int cvt_it = gw;
#define CONV_TILE() do { if (cvt_it < NEXP * 3 * 128) { const int e_ = cvt_it / 384, q_ = cvt_it % 384, m_ = q_ / 128, qq_ = q_ % 128, k0_ = 128 * (qq_ >> 4), n0_ = 64 * (qq_ & 15); \
            if (m_ < 2) p0_tile8((m_ == 0 ? w_gate : w_up) + (size_t)e_ * DM * DEXP, DEXP, Wgu8 + ((size_t)e_ * 2048 + (n0_ >> 7) * 256 + m_ * 128 + (n0_ & 127)) * DM, DM, nullptr, 512.0f, k0_, n0_, vst, lane); \
            else p0_tile8(w_down + (size_t)e_ * DEXP * DM, DM, Wd8 + ((size_t)e_ * DM + n0_) * DEXP, DEXP, nullptr, 512.0f, k0_, n0_, vst, lane); \
            cvt_it += NGW; } } while (0)
        static_assert((8 * (SZ0 + SZ1 + SZ2) + 512) * 4 + 8 * KVIMG <= RING_BYTES, "attention LDS");
        bf16* PB = (bf16*)(ws + WS_X1B);
        float* LS = (float*)(ws + WS_X1B + (size_t)NTOK * 512 * 2);
        for (int i = tid; i < 8 * (SZ0 + SZ1 + SZ2); i += 512) {
            int p, rem; if (i < 8 * SZ0) { p = 0; rem = i; } else if (i < 8 * (SZ0 + SZ1)) { p = 1; rem = i - 8 * SZ0; } else { p = 2; rem = i - 8 * (SZ0 + SZ1); }
            const int sz = p == 0 ? SZ0 : (p == 1 ? SZ1 : SZ2), pl = p == 0 ? PL0 : (p == 1 ? PL1 : PL2), hh = rem / sz, j = rem % sz - pl;
            float v = -1e30f;
            if (j >= 0 && j <= 128) { const int dist = j << (2 * p); int bkt = dist;
                if (dist >= 16) bkt = 16 + (dist >= 22) + (dist >= 30) + (dist >= 40) + (dist >= 54) + (dist >= 73) + (dist >= 99) + (dist >= 134) + (dist >= 182) + (dist >= 246)
                                         + (dist >= 332) + (dist >= 450) + (dist >= 609) + (dist >= 825) + (dist >= 1117) + (dist >= 1513);
                v = rel_bias[bkt * 8 + hh] * LOG2E; }
            tb0[i] = v;
        }
        __syncthreads();
        const int r32 = lane & 31, hi = lane >> 5, h = wid;
        int par = 0;
#define A_LOAD(T, tt_, NT_) A_LOADX(T, tt_, NT_, cr, base)
#define A_LOADX(T, tt_, NT_, cr_, base_) do { const int _t = (tt_) < (NT_) ? (tt_) : (NT_) - 1; A_DESC(_t, _p, _kt); const int _sh = 2 * _p, _kb = (cr_) - (128 << _sh) + ((32 * _kt) << _sh); \
            _Pragma("unroll") for (int _i = 0; _i < 4; ++_i) { int _pos = _kb + ((8 * _i + (lane >> 3)) << _sh); _pos = _pos < 0 ? 0 : (_pos > SEQ - 1 ? SEQ - 1 : _pos); \
                const bf16* _row = (base_) + (size_t)_pos * NQKV + h * 64 + (lane & 7) * 8; T.k[_i] = *(const GAS v4u*)(_row + 512); T.v[_i] = *(const GAS v4u*)(_row + 1024); } } while (0)
#define A_STEP(T, tt_, NT_, QS_) do { if ((tt_) < (NT_)) { A_DESC(tt_, p, kt); const int sh = 2 * p, kbase = cr - (128 << sh) + ((32 * kt) << sh); \
            if (kbase + (31 << sh) >= 0) { \
                kv_put(kst, vst, T, lane); \
                const LAS float* bp = (p == 0 ? tb0 + h * SZ0 + PL0 : (p == 1 ? tb1 + h * SZ1 + PL1 : tb2 + h * SZ2 + PL2)) + (128 - 32 * kt + (((QS_) >> sh) * r32) - 4 * hi - 27); \
                f32x16 bv; _Pragma("unroll") for (int r = 0; r < 16; ++r) bv[r] = bp[27 - ((r & 3) + 8 * (r >> 2))]; \
                bf16x8 vf[2][2]; v_frags(vf, vst, lane); \
                f32x16 s = qk_mma(kst, qf, lane); \
                __builtin_amdgcn_sched_barrier(0);     \
                f32x16 pe = s + bv; \
                if (__builtin_expect(kbase < 0, 0)) { asm volatile("; sequence start: keys before position 0 (a real branch, never if-converted)" ::: "memory"); \
                    _Pragma("unroll") for (int r = 0; r < 16; ++r) if (kbase + ((4 * hi + (r & 3) + 8 * (r >> 2)) << sh) < 0) pe[r] = -1e30f; } \
                float mx = fmaxf(fmaxf(pe[0], pe[1]), pe[2]);     \
                _Pragma("unroll") for (int r = 3; r < 15; r += 2) mx = fmaxf(fmaxf(mx, pe[r]), pe[r + 1]); \
                mx = fmaxf(mx, pe[15]); \
                mx = fmaxf(mx, __shfl_xor(mx, 32)); \
                  \
                  \
                if (__any(mx > m_run + 8.0f)) { const float m_new = fmaxf(m_run, mx), f = __builtin_amdgcn_exp2f(m_run - m_new); m_run = m_new; l_run *= f; \
                    _Pragma("unroll") for (int c = 0; c < 2; ++c) _Pragma("unroll") for (int r = 0; r < 16; ++r) o[c][r] *= f; } \
                _Pragma("unroll") for (int r = 0; r < 16; ++r) { pe[r] = __builtin_amdgcn_exp2f(pe[r] - m_run); l_run += pe[r]; } \
                bf16x8 pa[2]; pa[0] = pack8<0>(pe); pa[1] = pack8<8>(pe); \
                pv_mma(o, vf, pa); } } } while (0)
#define A_PRELOAD(NT_, cr_, base_, qpos_) do { A_LOADX(T0, 0, NT_, cr_, base_); A_LOADX(T1, 1, NT_, cr_, base_); \
            _Pragma("unroll") for (int d0 = 0; d0 < 4; ++d0) qf[d0] = *(const GAS bf16x8*)((base_) + (size_t)(qpos_) * NQKV + h * 64 + d0 * 16 + hi * 8); } while (0)
#define A_STREAM(NT_, QS_) do { \
            constexpr int _TS = (((NT_) - 5) / 3) * 3 + 3; \
            _Pragma("unroll 1") for (int tt = 0; tt + 4 < (NT_); tt += 3) { \
                A_LOAD(T2, tt + 2, NT_); A_STEP(T0, tt, NT_, QS_); \
                A_LOAD(T0, tt + 3, NT_); A_STEP(T1, tt + 1, NT_, QS_); \
                A_LOAD(T1, tt + 4, NT_); A_STEP(T2, tt + 2, NT_, QS_); } \
            if (_TS + 2 < (NT_)) A_LOAD(T2, _TS + 2, NT_); A_STEP(T0, _TS, NT_, QS_); \
            if (_TS + 3 < (NT_)) A_LOAD(T0, _TS + 3, NT_); if (_TS + 1 < (NT_)) A_STEP(T1, _TS + 1, NT_, QS_); \
            if (_TS + 4 < (NT_)) A_LOAD(T1, _TS + 4, NT_); if (_TS + 2 < (NT_)) A_STEP(T2, _TS + 2, NT_, QS_); \
            if (_TS + 3 < (NT_)) A_STEP(T0, _TS + 3, NT_, QS_); \
            static_assert(_TS % 3 == 0 && _TS + 4 >= (NT_) && _TS < (NT_), "stream tail"); } while (0)
#define A_DESC(tt, p_, kt_) const int p_ = 2, kt_ = (tt)
#pragma unroll 1
        for (int rep = 0; rep < REP_A; ++rep) { KVt T0, T1, T2; bf16x8 qf[4]; bool pre = false;
        for (int q = 0; vcu + (q >> 2) * G < BATCH * 16 * 4; ++q) {
            const int sup = vcu + (q >> 2) * G, b = sup >> 6, ch = (sup >> 2) & 15, rho = (sup & 3) + 4 * (q & 3), cr = 512 * ch + rho;
            const int qpos = cr + 16 * r32;
            const bf16* base = QKV + (size_t)b * SEQ * NQKV;
            if (!pre) A_PRELOAD(5, cr, base, qpos);
            f32x16 o[2]; o[0] = f32x16{}; o[1] = f32x16{};
            float m_run = -1e20f, l_run = 0.f;
            A_STREAM(5, 16);
            const bool conv = rep == 0 && ((q + bx) & 3) == 3;
            pre = false && (vcu + ((q + 1) >> 2) * G < BATCH * 16 * 4) && !conv;
            if (pre) { const int supn = vcu + ((q + 1) >> 2) * G, bn = supn >> 6, crn = 512 * ((supn >> 2) & 15) + (supn & 3) + 4 * ((q + 1) & 3); A_PRELOAD(5, crn, QKV + (size_t)bn * SEQ * NQKV, crn + 16 * r32); }
            l_run += __shfl_xor(l_run, 32);
            const float inv = 1.0f / l_run;
            { v4u w4[4];
#pragma unroll
              for (int c = 0; c < 2; ++c)
#pragma unroll
                  for (int gp = 0; gp < 2; ++gp)
#pragma unroll
                      for (int t = 0; t < 4; ++t) w4[2 * c + gp][t] = pg8::cvt_pk_bf16(o[c][8 * gp + 2 * t] * inv, o[c][8 * gp + 2 * t + 1] * inv);
              xp32_store(vst, w4, PB + ((size_t)b * SEQ + cr) * 512 + h * 64, (size_t)16 * 512, lane); }
            if (hi == 0) LS[((size_t)b * SEQ + qpos) * 8 + h] = m_run + __builtin_amdgcn_logf(l_run);
            __builtin_amdgcn_s_barrier();
            if (conv) CONV_TILE();
        } }
#undef A_DESC
        bf16x8 Tm[2];
#pragma unroll
        for (int ks = 0; ks < 2; ++ks) { v4u w;
#pragma unroll
            for (int jj = 0; jj < 4; ++jj) { const unsigned a = (crow(8 * ks + 2 * jj, hi) >= r32) ? 0x3F80u : 0u, bq = (crow(8 * ks + 2 * jj + 1, hi) >= r32) ? 0x3F80u : 0u; w[jj] = a | (bq << 16); }
            Tm[ks] = __builtin_bit_cast(bf16x8, w); }
#define B_LOAD(T, k_) B_LOADX(T, k_, base)
#define B_LOADX(T, k_, base_) do { const int _k = (k_) < 0 ? 0 : (k_); \
            _Pragma("unroll") for (int _i = 0; _i < 4; ++_i) { const bf16* _row = (base_) + (size_t)(_k + 8 * _i + (lane >> 3)) * NQKV + h * 64 + (lane & 7) * 8; \
                T.k[_i] = *(const GAS v4u*)(_row + 2048); T.v[_i] = *(const GAS v4u*)(_row + 2560); } } while (0)
#define B_STEP(T, k0, DIAG) do { \
            kv_put(kst, vst, T, lane); \
            f32x16 z = qk_mma(kst, qf, lane); \
            f32x16 sp; \
            _Pragma("unroll") for (int r = 0; r < 16; ++r) { z[r] = fminf(z[r], 126.0f); \
                const float v = __builtin_amdgcn_logf(1.0f + __builtin_amdgcn_exp2f(z[r])); \
                sp[r] = (!(DIAG) || ((k0) + crow(r, hi)) < qpos) ? v : 0.f; } \
            bf16x8 sb[2]; sb[0] = pack8<0>(sp); sb[1] = pack8<8>(sp); \
            f32x16 cs; \
            _Pragma("unroll") for (int r = 0; r < 16; ++r) cs[r] = carry; \
            cs = __builtin_amdgcn_mfma_f32_32x32x16_bf16(Tm[0], sb[0], cs, 0, 0, 0); \
            cs = __builtin_amdgcn_mfma_f32_32x32x16_bf16(Tm[1], sb[1], cs, 0, 0, 0); \
            f32x16 pe; \
            _Pragma("unroll") for (int r = 0; r < 16; ++r) { const float v = __builtin_amdgcn_exp2f(z[r] - cs[r]); pe[r] = (!(DIAG) || ((k0) + crow(r, hi)) < qpos) ? v : 0.f; } \
            bf16x8 pa[2]; pa[0] = pack8<0>(pe); pa[1] = pack8<8>(pe); \
            pv_tile(o, vst, pa, lane); \
            carry = __shfl(cs[0], r32); } while (0)
#define B_DONE(k0) ((k0) == 0 || __all(carry > 150.0f))
#pragma unroll 1
        for (int rep = 0; rep < REP_B; ++rep) { KVt T0, T1, T2; bf16x8 qf[4]; bool pre = false;
#define B_PRELOAD(t0_, base_, qpos_) do { B_LOADX(T0, t0_, base_); B_LOADX(T1, (t0_) - 32, base_); \
            _Pragma("unroll") for (int d0 = 0; d0 < 4; ++d0) qf[d0] = *(const GAS bf16x8*)((base_) + (size_t)(qpos_) * NQKV + 1536 + h * 64 + d0 * 16 + hi * 8); } while (0)
        for (int item = vcu; item < BATCH * (SEQ / 32); item += G, par ^= 1) {
            const int b = item >> 8, qt = item & 255, t0 = 32 * qt, qpos = t0 + r32;
            const bf16* base = QKV + (size_t)b * SEQ * NQKV;
            if (!pre) B_PRELOAD(t0, base, qpos);
            f32x16 o[2]; o[0] = f32x16{}; o[1] = f32x16{};
            float carry = 0.f;
            int k0 = t0;
            B_LOAD(T2, k0 - 64); B_STEP(T0, k0, true);
            if (!B_DONE(k0)) { k0 -= 32;
#pragma unroll 1
                for (;;) {
                    B_LOAD(T0, k0 - 64); B_STEP(T1, k0, false); if (B_DONE(k0)) break; k0 -= 32;
                    B_LOAD(T1, k0 - 64); B_STEP(T2, k0, false); if (B_DONE(k0)) break; k0 -= 32;
                    B_LOAD(T2, k0 - 64); B_STEP(T0, k0, false); if (B_DONE(k0)) break; k0 -= 32;
                } }
            const bool conv = rep == 0 && ((((item - vcu) / G) + bx) & 3) == 3;
            pre = (item + G < BATCH * (SEQ / 32)) && !conv;
            if (pre) { const int itn = item + G, bn = itn >> 8, t0n = 32 * (itn & 255); B_PRELOAD(t0n, QKV + (size_t)bn * SEQ * NQKV, t0n + r32); }
            attn_store(o, 1.0f, xsb + par * 256, vst, OB + ((size_t)b * SEQ + (qpos - r32)) * DM + 512 + h * 64, (size_t)DM, wid, lane);
            if (conv) CONV_TILE();
        } }
#undef B_PRELOAD
#undef B_LOADX
#undef B_LOAD
#undef B_STEP
#undef B_DONE
        VM_WAIT();
#define A_DESC(tt, p_, kt_) const int p_ = ((tt) >= 8) ? 1 : 0, kt_ = (tt) - (p_ ? 8 : 0)
#pragma unroll 1
        for (int rep = 0; rep < REP_A; ++rep) { KVt T0, T1, T2; bf16x8 qf[4]; bool pre = false;
        for (int q = 0; vcu + (q >> 2) * G < BATCH * 16 * 4; ++q, par ^= 1) {
            const int sup = vcu + (q >> 2) * G, b = sup >> 6, blk = 4 * ((sup >> 2) & 15) + (q & 3), rho = sup & 3, cr = 128 * blk + rho;
            const int qpos = cr + 4 * r32;
            const bf16* base = QKV + (size_t)b * SEQ * NQKV;
            if (!pre) A_PRELOAD(13, cr, base, qpos);
            f32x16 o[2]; o[0] = f32x16{}; o[1] = f32x16{};
            float m_run = -1e20f, l_run = 0.f;
            v4u pt[4];
            xp32_load(pt, PB + ((size_t)b * SEQ + cr) * 512 + h * 64, (size_t)4 * 512, lane);
            const float lse3 = LS[((size_t)b * SEQ + qpos) * 8 + h];
            A_STREAM(13, 4);
            const bool conv = rep == 0 && ((q + bx) & 3) == 3;
            pre = false && (vcu + ((q + 1) >> 2) * G < BATCH * 16 * 4) && !conv;
            if (pre) { const int supn = vcu + ((q + 1) >> 2) * G, bn = supn >> 6, crn = 128 * (4 * ((supn >> 2) & 15) + ((q + 1) & 3)) + (supn & 3); A_PRELOAD(13, crn, QKV + (size_t)bn * SEQ * NQKV, crn + 4 * r32); }
            l_run += __shfl_xor(l_run, 32);
            { v4u pw4[4]; xp32_unpack(vst, pt, pw4, lane);
              const float m = fmaxf(m_run, lse3), a12 = __builtin_amdgcn_exp2f(m_run - m), a3 = __builtin_amdgcn_exp2f(lse3 - m);
              l_run = l_run * a12 + a3;
#pragma unroll
              for (int c = 0; c < 2; ++c)
#pragma unroll
                  for (int gp = 0; gp < 2; ++gp)
#pragma unroll
                      for (int t = 0; t < 4; ++t) { o[c][8 * gp + 2 * t] = o[c][8 * gp + 2 * t] * a12 + bflo(pw4[2 * c + gp][t]) * a3; o[c][8 * gp + 2 * t + 1] = o[c][8 * gp + 2 * t + 1] * a12 + bfhi(pw4[2 * c + gp][t]) * a3; } }
            attn_store(o, 1.0f / l_run, xsb + par * 256, vst, OB + ((size_t)b * SEQ + cr) * DM + h * 64, (size_t)4 * DM, wid, lane);
            if (conv) CONV_TILE();
        } }
        while (cvt_it < NEXP * 3 * 128) CONV_TILE();
#undef CONV_TILE
#undef A_DESC
#undef A_LOAD
#undef A_LOADX
#undef A_PRELOAD
#undef A_STEP
#undef A_STREAM
    }
    GRID_BAR();

#pragma unroll 1
    for (int rep = 0; rep < REP_P3; ++rep) {
        ENV();
        bf16* Wo_t = (bf16*)(ws + WS_WO); bf16* OB = (bf16*)(ws + WS_O); bf16* X1B = (bf16*)(ws + WS_X1B); unsigned char* X1Q = ws + WS_X1Q;
        pg8::DenseOrder S; S.init(NTOK, DM, DM, G, bx, Wo_t);
        pg8::EpiWo E{(const pg8::bf16_t*)(ws + WS_XN), (const float*)(ws + WS_RMS1), X1B, X1Q, IN(7)};
        pg8::gemm_phase<pg8::EpiWo, pg8::DenseOrder>(lds, OB, DM, S, E, wid_s);
    }
    GRID_BAR();

    {
        ENV();
        const float* g_moe = IN(7); const float* w_router = IN(8); const float* b_router = IN(9); const bf16* X1B = (const bf16*)(ws + WS_X1B);
        int* tok_list = (int*)(ws + WS_TOK); float* gate_list = (float*)(ws + WS_GATE); float* rs_list = (float*)(ws + WS_RS); int* dst_list = (int*)(ws + WS_DST);
        unsigned* cnt_g = (unsigned*)(ws + WS_CTL) + CW_CNT;
        LAS unsigned short* Wt = (LAS unsigned short*)lds;
        LAS unsigned* hist = (LAS unsigned*)(lds + HIST_OFF); LAS unsigned* basel = (LAS unsigned*)(lds + BASE_OFF);
        for (int s = tid; s < DM * NEXP; s += 512) { const int k = s >> 5, e = s & 31; const float w = g_moe[k] * w_router[s];
            const unsigned wh = f2bf(w); const unsigned wl_ = f2bf(w - __builtin_bit_cast(float, wh << 16));
            const int idx = (((k >> 4) * 2 + ((k >> 3) & 1)) * 32 + e) * 16 + (k & 7); Wt[idx] = (unsigned short)wh; Wt[idx + 8] = (unsigned short)wl_; }
        if (tid < 32) hist[tid] = 0u;
        __syncthreads();
        const int r32 = lane & 31, hi = lane >> 5;
        for (int chunk = bx; chunk < NTOK / 256; chunk += G) {
            const int row = chunk * 256 + wid * 32 + r32;
            const GAS v4u* xr = (const GAS v4u*)(X1B + (size_t)row * DM + 8 * hi);
            const LAS bf16x8* wl = (const LAS bf16x8*)Wt + (hi * 32 + r32) * 2;
            f32x16 acc = {}; float ssq = 0.f;
#pragma unroll 4
            for (int i = 0; i < 64; ++i) { const v4u xv = xr[2 * i]; const bf16x8 wh = wl[i * 128], wlo = wl[i * 128 + 1];
                const bf16x8 xb = __builtin_bit_cast(bf16x8, xv);
                acc = __builtin_amdgcn_mfma_f32_32x32x16_bf16(wh, xb, acc, 0, 0, 0); acc = __builtin_amdgcn_mfma_f32_32x32x16_bf16(wlo, xb, acc, 0, 0, 0);
                const float v0 = bflo(xv.x), v1 = bfhi(xv.x), v2 = bflo(xv.y), v3 = bfhi(xv.y), v4 = bflo(xv.z), v5 = bfhi(xv.z), v6 = bflo(xv.w), v7 = bfhi(xv.w);
                ssq += ((v0 * v0 + v1 * v1) + (v2 * v2 + v3 * v3)) + ((v4 * v4 + v5 * v5) + (v6 * v6 + v7 * v7)); }
            ssq += __shfl_xor(ssq, 32);
            const float rstd2 = 1.0f / sqrtf(ssq * (1.0f / DM) + RMS_EPS);
            float lg[16];
#pragma unroll
            for (int r = 0; r < 16; ++r) lg[r] = acc[r] * rstd2 + b_router[crow(r, hi)];
            float tv[4]; int ti[4];
#pragma unroll
            for (int k = 0; k < 4; ++k) {
                float bv = lg[0]; int bi = crow(0, hi);
#pragma unroll
                for (int r = 1; r < 16; ++r) { if (lg[r] > bv) { bv = lg[r]; bi = crow(r, hi); } }
                const float pv = __shfl_xor(bv, 32); const int pi = __shfl_xor(bi, 32);
                const bool mine = (bv > pv) || (bv == pv && bi < pi);
                tv[k] = mine ? bv : pv; ti[k] = mine ? bi : pi;
#pragma unroll
                for (int r = 0; r < 16; ++r) if (mine && crow(r, hi) == bi) lg[r] = -3.0e38f;
            }
            float ge[4]; float gs = 0.f;
#pragma unroll
            for (int k = 0; k < 4; ++k) { ge[k] = __builtin_amdgcn_exp2f((tv[k] - tv[0]) * LOG2E); gs += ge[k]; }
            const float ginv = 1.0f / gs;
            unsigned rank[4] = {0u, 0u, 0u, 0u};
            if (hi == 0) {
#pragma unroll
                for (int k = 0; k < 4; ++k) rank[k] = __hip_atomic_fetch_add(hist + ti[k], 1u, __ATOMIC_RELAXED, __HIP_MEMORY_SCOPE_WORKGROUP);
            }
            __syncthreads();
            if (tid < 32) basel[tid] = __hip_atomic_fetch_add(cnt_g + tid, hist[tid], RLX_AGENT);
            __syncthreads();
            if (hi == 0) {
#pragma unroll
                for (int k = 0; k < 4; ++k) { const size_t li = (size_t)ti[k] * NTOK + basel[ti[k]] + rank[k];
                    tok_list[li] = row; gate_list[li] = ge[k] * ginv; rs_list[li] = rstd2; dst_list[li] = row * 4 + k; }
            }
            __syncthreads();
            if (tid < 32) hist[tid] = 0u;
            __syncthreads();
        }
    }
    GRID_BAR();

    LAS int* cntl = (LAS int*)(lds + CNTL_OFF); LAS int* firstl = (LAS int*)(lds + FIRST_OFF); LAS int* rbtab = (LAS int*)(lds + RBTAB_OFF);
    {
    ENV();
    unsigned* cnt_g = (unsigned*)(ws + WS_CTL) + CW_CNT;
    if (tid < 64) {
        int c = 0; if (tid < 32) c = (int)__hip_atomic_load(cnt_g + tid, RLX_AGENT);
        const int nrb = (c + 255) >> 8; int inc = nrb;
#pragma unroll
        for (int o = 1; o < 32; o <<= 1) { const int t = __shfl_up(inc, o); if ((tid & 31) >= o) inc += t; }
        if (tid < 32) { cntl[tid] = c; firstl[tid] = inc - nrb; if (tid == 31) firstl[32] = inc; }
    }
    __syncthreads();
    const int nRB0 = firstl[32];
    for (int rb = tid; rb < nRB0; rb += 512) { int e = 0;
#pragma unroll 1
        for (int q = 1; q < 32; ++q) e += (firstl[q] <= rb) ? 1 : 0;
        rbtab[rb] = (e << 16) | (rb - firstl[e]); }
    __syncthreads();
    }
    const int nRB = __builtin_amdgcn_readfirstlane(firstl[32]);

#pragma unroll 1
    for (int rep = 0; rep < REP_P5; ++rep) {
        ENV();
        const float* b_gate = IN(11); const float* b_up = IN(13); unsigned char* Wgu8 = ws + WS_WGU; unsigned char* X1Q = ws + WS_X1Q; unsigned char* ACT = ws + WS_ACT;
        int* tok_list = (int*)(ws + WS_TOK); float* rs_list = (float*)(ws + WS_RS);
        pg8::MoeOrder<true> S{G, bx, 8, nRB, DM / 2, (const char*)Wgu8, (size_t)2048 * DM, rbtab, cntl, tok_list, lds + UTAB_OFF, rs_list, nullptr, b_gate, b_up};
        pg8::EpiGU E{ACT, lds + UTAB_OFF};
        pg8::gemm_phase<pg8::EpiGU, pg8::MoeOrder<true>, true>(lds, X1Q, DM / 2, S, E, wid_s);
    }
    GRID_BAR();

#pragma unroll 1
    for (int rep = 0; rep < REP_P6; ++rep) {
        ENV();
        const float* b_down = IN(15); unsigned char* Wd8 = ws + WS_WD; unsigned char* ACT = ws + WS_ACT;
        float* gate_list = (float*)(ws + WS_GATE); int* dst_list = (int*)(ws + WS_DST);
        pg8::MoeOrder<false> S{G, bx, 4, nRB, DEXP / 2, (const char*)Wd8, (size_t)DM * DEXP, rbtab, cntl, nullptr, lds + UTAB_OFF, gate_list, dst_list, b_down, nullptr};
        pg8::EpiDown E{(unsigned char*)out, lds + UTAB_OFF};
        pg8::gemm_phase<pg8::EpiDown, pg8::MoeOrder<false>, true>(lds, ACT, DEXP / 2, S, E, wid_s);
    }
    GRID_BAR();

    {
        ENV();
        const float* g_final = IN(16); bf16* X1B = (bf16*)(ws + WS_X1B); const unsigned char* Y = (const unsigned char*)out;
        f32x4 gf[4];
#pragma unroll
        for (int q = 0; q < 4; ++q) gf[q] = *(const f32x4*)(g_final + 16 * lane + 4 * q);
#define P7_LOAD(XA, YA, M0) do { _Pragma("unroll") for (int t = 0; t < 2; ++t) { \
                _Pragma("unroll") for (int j = 0; j < 2; ++j) XA[t][j] = *(const GAS v4u*)(X1B + (size_t)((M0) + t) * DM + 16 * lane + 8 * j); \
                _Pragma("unroll") for (int k = 0; k < 4; ++k) YA[t][k] = *(const GAS v4u*)(Y + ((size_t)((M0) + t) * 4 + k) * DM + 16 * lane); } } while (0)
        v4u xa[2][2], ya[2][4], xn2[2][2], yn2[2][4];
        if (2 * gw < NTOK) P7_LOAD(xa, ya, 2 * gw);
#pragma unroll 1
        for (int m0 = 2 * gw; m0 < NTOK; m0 += 2 * NGW) {
            const bool more = m0 + 2 * NGW < NTOK;
            if (more) P7_LOAD(xn2, yn2, m0 + 2 * NGW);
#pragma unroll
            for (int t = 0; t < 2; ++t) {
                float v[16]; float s2 = 0.f;
#pragma unroll
                for (int q = 0; q < 4; ++q) {
                    float y0 = 0.f, y1 = 0.f, y2 = 0.f, y3 = 0.f;
#pragma unroll
                    for (int k = 0; k < 4; ++k) { const auto lo = __builtin_amdgcn_cvt_pk_f32_fp8((int)ya[t][k][q], false), hh = __builtin_amdgcn_cvt_pk_f32_fp8((int)ya[t][k][q], true);
                        y0 += lo[0]; y1 += lo[1]; y2 += hh[0]; y3 += hh[1]; }
                    const unsigned w0 = xa[t][q >> 1][(q & 1) * 2], w1 = xa[t][q >> 1][(q & 1) * 2 + 1];
                    v[4 * q] = bflo(w0) + y0 * (1.0f / 8.0f); v[4 * q + 1] = bfhi(w0) + y1 * (1.0f / 8.0f); v[4 * q + 2] = bflo(w1) + y2 * (1.0f / 8.0f); v[4 * q + 3] = bfhi(w1) + y3 * (1.0f / 8.0f);
                    s2 += (v[4 * q] * v[4 * q] + v[4 * q + 1] * v[4 * q + 1]) + (v[4 * q + 2] * v[4 * q + 2] + v[4 * q + 3] * v[4 * q + 3]); }
                const float rstd = 1.0f / sqrtf(wave_sum(s2) * (1.0f / DM) + RMS_EPS);
                GAS f32x4* op = (GAS f32x4*)(out + (size_t)(m0 + t) * DM + 16 * lane);
#pragma unroll
                for (int q = 0; q < 4; ++q) op[q] = (f32x4){v[4 * q] * rstd * gf[q].x, v[4 * q + 1] * rstd * gf[q].y, v[4 * q + 2] * rstd * gf[q].z, v[4 * q + 3] * rstd * gf[q].w};
            }
            if (more) {
#pragma unroll
                for (int t = 0; t < 2; ++t) {
#pragma unroll
                    for (int j = 0; j < 2; ++j) xa[t][j] = xn2[t][j];
#pragma unroll
                    for (int k = 0; k < 4; ++k) ya[t][k] = yn2[t][k]; } }
        }
#undef P7_LOAD
    }
}

extern "C" void kernel_launch(void* const* d_in, const int* in_sizes, int n_in, void* d_out, int out_size, void* d_ws, size_t ws_size, hipStream_t stream) {
    static int grid = 0;
    if (grid == 0) {
        if (n_in != 17 || out_size != NTOK * DM || ws_size < WS_END) { fprintf(stderr, "kernel_launch: unexpected shapes (n_in %d, out %d, ws %zu)\n", n_in, out_size, ws_size); grid = -1; return; }
        int dev = 0, cus = 0;
        if (hipGetDevice(&dev) != hipSuccess || hipDeviceGetAttribute(&cus, hipDeviceAttributeMultiprocessorCount, dev) != hipSuccess) { grid = -1; return; }
        if (hipFuncSetAttribute((const void*)hybrid_fwd, hipFuncAttributeMaxDynamicSharedMemorySize, LDS_BYTES) != hipSuccess) { grid = -1; return; }
        int per_cu = 0;
        if (hipOccupancyMaxActiveBlocksPerMultiprocessor(&per_cu, (const void*)hybrid_fwd, 512, LDS_BYTES) != hipSuccess || per_cu < 1) { fprintf(stderr, "kernel_launch: occupancy query says %d\n", per_cu); }
        (void)hipGetLastError();
        grid = cus;
    }
    if (grid < 0) return;
    if (hipMemsetAsync((char*)d_ws + WS_CTL, 0, CTL_ZERO_BYTES, stream) != hipSuccess) return;
    Args a{};
    for (int i = 0; i < 17; ++i) a.in[i] = (const float*)d_in[i];
    a.out = (float*)d_out; a.ws = (unsigned char*)d_ws;
    hipLaunchKernelGGL(hybrid_fwd, dim3(grid), dim3(512), LDS_BYTES, stream, a);
}
```

```cpp
#include <hip/hip_runtime.h>
#include <cstdio>
#include <cstdint>

#define GAS __attribute__((address_space(1)))
#define LAS __attribute__((address_space(3)))
#ifndef REP_P0
#define REP_P0 1
#endif
#ifndef REP_P1
#define REP_P1 1
#endif
#ifndef REP_A
#define REP_A 1
#endif
#ifndef REP_B
#define REP_B 1
#endif
#ifndef REP_P3
#define REP_P3 1
#endif
#ifndef REP_P5
#define REP_P5 1
#endif
#ifndef REP_P6
#define REP_P6 1
#endif
#ifndef KREP_P1
#define KREP_P1 1
#endif
#ifndef EREP_P1
#define EREP_P1 1
#endif
#ifndef REP_P1_UNITS
#define REP_P1_UNITS 12
#endif
#ifndef KREP_P5
#define KREP_P5 1
#endif

constexpr int BATCH = 8, SEQ = 8192, DM = 1024, NTOK = BATCH * SEQ;
constexpr int NQKV = 3072, NEXP = 32, TOPK = 4, DEXP = 1024;
constexpr int MAXRB = NTOK * TOPK / 256 + NEXP;
constexpr int NSLOT = MAXRB * 256;
constexpr float RMS_EPS = 1e-6f;
constexpr float LOG2E = 1.4426950408889634f;
constexpr float QSCALE = 0.125f * LOG2E;

namespace pg8 {
#define PG8_LAS __attribute__((address_space(3)))
typedef unsigned short bf16_t;
typedef short bf16x8 __attribute__((ext_vector_type(8)));
typedef float f32x4 __attribute__((ext_vector_type(4)));
typedef unsigned u32x4 __attribute__((ext_vector_type(4)));
typedef unsigned u32x2 __attribute__((ext_vector_type(2)));
constexpr int BM = 256, BK = 64, HALF = 128, HTB = HALF * BK * 2, STAGE_BYTES = 8 * HTB, NXCD = 8, WGM = 8;

__host__ __device__ __forceinline__ int lds_chunk(int r, int c) { return (r >> 3) * 1024 + (r & 7) * 128 + ((c ^ ((r >> 1) & 7)) << 4); }
__host__ __device__ __forceinline__ void stage_rc(int b, int& R, int& C) { R = (b >> 10) * 8 + ((b >> 7) & 7); C = ((((b >> 4) & 7) ^ ((R >> 1) & 7))) * 8; }
__host__ __device__ __forceinline__ int perm32(int rho) { const int n = rho >> 4, i = rho & 15; return 8 * (i >> 2) + 4 * n + (i & 3); }

__device__ __forceinline__ int lane_now() { unsigned z = 0u; asm volatile("" : "+s"(z)); return (int)__builtin_amdgcn_mbcnt_hi(~0u, __builtin_amdgcn_mbcnt_lo(~0u, z)); }
struct Unit { int pm, pn, e, r0, nv; };

typedef float f32x2_cv __attribute__((ext_vector_type(2))); typedef __bf16 bf16x2_cv __attribute__((ext_vector_type(2)));
__device__ __forceinline__ unsigned cvt_pk_bf16(float lo, float hi) { const f32x2_cv v = {lo, hi}; const bf16x2_cv b = __builtin_convertvector(v, bf16x2_cv); return __builtin_bit_cast(unsigned, b); }

struct DenseOrder {
    int nM, nN, nwg, G, c, K; const char* Bt; int maxi = 1 << 30;
    __device__ void init(int M, int N, int K_, int G_, int c_, const void* Bt_) { nM = M / BM; nN = N / BM; nwg = nM * nN; G = G_; c = c_; K = K_; Bt = (const char*)Bt_; }
    __device__ __forceinline__ bool next(int i, Unit& u) const {
        const long L = (long)i * G + c; if (L >= nwg || i >= maxi) return false;
        int wgid = (int)L; { const int q = nwg / NXCD, r = nwg % NXCD, xcd = wgid % NXCD, off = wgid / NXCD; wgid = (xcd < r ? xcd * (q + 1) : r * (q + 1) + (xcd - r) * q) + off; }
        const int nig = WGM * nN, gid = wgid / nig, fm = gid * WGM, gsz = (nM - fm) < WGM ? (nM - fm) : WGM;
        u.pm = fm + ((wgid % nig) % gsz); u.pn = (wgid % nig) / gsz; u.e = 0; u.r0 = 0; u.nv = 256; return true;
    }
    static constexpr bool GATHER = false;
    static constexpr int BPAD = 64;
    __device__ __forceinline__ const char* bbase(const Unit& u) const { return Bt + (size_t)u.pn * BM * (K + BPAD) * 2; }
    __device__ __forceinline__ size_t abase(const Unit& u) const { return (size_t)u.pm * BM * K * 2; }
    __device__ __forceinline__ void aoffs(const Unit&, int, unsigned (&)[2][2]) const {}
    __device__ __forceinline__ void aoffs_lds(const Unit&, int, int, unsigned (&)[2][2]) const {}
    __device__ __forceinline__ void unit_begin(const Unit&, const Unit&, bool, int, int, int) const {}
};
constexpr int UT_TOK = 0, UT_ROWA = 1024, UT_ROWB = 2048, UT_BIAS = 3072, UT_BYTES = 4096;
template <bool GATHER_> struct MoeOrder {
    static constexpr bool GATHER = GATHER_; static constexpr int BPAD = 0;
    int G, c, NT, nRB, K; const char* W; size_t wstride; const PG8_LAS int* rbtab; const PG8_LAS int* cntl; const int* tok_list;
    PG8_LAS unsigned char* utab;
    const float* rowa; const int* rowb; const float* bias0; const float* bias1;
    __device__ __forceinline__ bool next(int i, Unit& u) const {
        const int L = i * G + c, x = L & 7, v = L >> 3, nper = (nRB + 7) >> 3, rl = v / NT, j = v % NT, rb = x * nper + rl;
        if (rl >= nper || rb >= nRB) return false;
        const int pk = __builtin_amdgcn_readfirstlane(rbtab[rb]); u.e = pk >> 16; u.pm = rb; u.pn = j; u.r0 = (pk & 0xffff) * 256;
        const int left = __builtin_amdgcn_readfirstlane(cntl[u.e]) - u.r0; u.nv = left < 256 ? left : 256; return true;
    }
    __device__ __forceinline__ const char* bbase(const Unit& u) const { return W + (size_t)u.e * wstride + (size_t)u.pn * BM * K * 2; }
    __device__ __forceinline__ size_t abase(const Unit& u) const { return GATHER ? (size_t)0 : (size_t)u.pm * BM * K * 2; }
    __device__ __forceinline__ void aoffs(const Unit& u, int tid, unsigned (&o)[2][2]) const {
        if (GATHER) {
            asm volatile("" : "+v"(tid));
            int tok[2][2];
#pragma unroll
            for (int i = 0; i < 2; ++i) { int R, C; stage_rc(tid * 16 + i * 8192, R, C);
#pragma unroll
                for (int h = 0; h < 2; ++h) { const int rl = h * HALF + R, rc = rl < u.nv ? rl : u.nv - 1; tok[h][i] = tok_list[(size_t)u.e * NTOK + u.r0 + rc]; } }
#pragma unroll
            for (int i = 0; i < 2; ++i) { int R, C; stage_rc(tid * 16 + i * 8192, R, C);
#pragma unroll
                for (int h = 0; h < 2; ++h) o[h][i] = (unsigned)(tok[h][i] * K + C) * 2u; }
        }
    }
    __device__ __forceinline__ void aoffs_lds(const Unit& u, int wid, int ui, unsigned (&o)[2][2]) const {
        if (GATHER) {
            const int tid = wid * 64 + lane_now();
            const PG8_LAS int* tt = (const PG8_LAS int*)(utab + (ui & 1) * UT_BYTES + UT_TOK);
#pragma unroll
            for (int i = 0; i < 2; ++i) { int R, C; stage_rc(tid * 16 + i * 8192, R, C);
#pragma unroll
                for (int h = 0; h < 2; ++h) { const int rl = h * HALF + R; const int tok = rl < u.nv ? tt[rl] : 0; o[h][i] = (unsigned)(tok * K + C) * 2u; } }
        }
    }
    __device__ __forceinline__ void unit_begin(const Unit& cur, const Unit& nxt, bool has_next, int ui, int wid, int lane) const {
        PG8_LAS unsigned char* tb = utab + (ui & 1) * UT_BYTES;
        const size_t li = (size_t)cur.e * NTOK + cur.r0;
        (void)lane;
        const unsigned lo = (unsigned)lane_now() * 4u;
#define PG8_DMA4(gptr, ldsptr) __builtin_amdgcn_global_load_lds((const unsigned*)((const char*)(gptr) + lo), (PG8_LAS unsigned*)(ldsptr), 4, 0, 0)
        if (wid < 4) {
            PG8_DMA4(rowa + li + 64 * wid, tb + UT_ROWA + 256 * wid);
            if (GATHER && has_next) PG8_DMA4(tok_list + (size_t)nxt.e * NTOK + nxt.r0 + 64 * wid, tb + UT_TOK + 256 * wid);
        } else {
            const int q = wid - 4;
            if (GATHER) PG8_DMA4((q < 2 ? bias0 : bias1) + (size_t)cur.e * DEXP + cur.pn * HALF + 64 * (q & 1), tb + UT_BIAS + 256 * q);
            else { PG8_DMA4(bias0 + (size_t)cur.e * DM + cur.pn * BM + 64 * q, tb + UT_BIAS + 256 * q);
                PG8_DMA4(rowb + li + 64 * q, tb + UT_ROWB + 256 * q); }
        }
#undef PG8_DMA4
    }
};

struct XposeRows {
    PG8_LAS unsigned char* xw; int wa, rd;
    __device__ __forceinline__ void init(PG8_LAS unsigned char* xs, int wid, int fr, int fq) { const int lane = fq * 16 + fr; xw = xs + wid * 2048;
        wa = fr * 128 + (((2 * fq) ^ (fr & 7)) << 4); rd = (lane >> 3) * 128 + (((lane & 7) ^ (lane >> 3)) << 4); }
    __device__ __forceinline__ void run(const u32x4& a0, const u32x4& a1, u32x4& d0, u32x4& d1) const {
        *(PG8_LAS u32x4*)(xw + wa) = a0; *(PG8_LAS u32x4*)(xw + (wa ^ 16)) = a1;
        __builtin_amdgcn_wave_barrier();
        d0 = *(const PG8_LAS u32x4*)(xw + rd); d1 = *(const PG8_LAS u32x4*)(xw + rd + 1024);
        __builtin_amdgcn_wave_barrier(); }
};
struct EpiQKV {
    static constexpr bool PERM = true, PERM16 = true; static constexpr int NSTORE = 16;
    bf16_t* O; int ldc; PG8_LAS unsigned char* xs;
    __device__ __forceinline__ void operator()(const f32x4 (&acc)[2][2][4][2], const Unit& u, int, int wr, int wc, int fr, int fq) const {
        const int lane = fq * 16 + fr;
        XposeRows X; X.init(xs, wr * 4 + wc, fr, fq);
        bf16_t* const p0 = O + (size_t)(u.pm * BM + wr * 64 + (lane >> 3)) * ldc + u.pn * BM + wc * 64 + 8 * (lane & 7);
#pragma unroll
        for (int ai = 0; ai < 2; ++ai)
#pragma unroll
            for (int m = 0; m < 4; ++m) { bf16_t* rowp = p0 + (size_t)(ai * HALF + m * 16) * ldc;
                u32x4 own[2];
#pragma unroll
                for (int bj = 0; bj < 2; ++bj) { const f32x4 v0 = acc[ai][bj][m][0] * (1.0f / KREP_P1), v1 = acc[ai][bj][m][1] * (1.0f / KREP_P1);
                    own[bj].x = cvt_pk_bf16(v0[0], v0[1]); own[bj].y = cvt_pk_bf16(v0[2], v0[3]); own[bj].z = cvt_pk_bf16(v1[0], v1[1]); own[bj].w = cvt_pk_bf16(v1[2], v1[3]); }
                u32x4 d0, d1; X.run(own[0], own[1], d0, d1);
                *(u32x4*)rowp = d0; *(u32x4*)(rowp + (size_t)8 * ldc) = d1; }
    }
};
struct EpiWo {
    static constexpr bool PERM = true, PERM16 = true; static constexpr int NSTORE = 24;
    const bf16_t* XNp; const float* RMS; bf16_t* X1b; unsigned char* X1q; const float* GM;
    __device__ __forceinline__ void operator()(const f32x4 (&acc)[2][2][4][2], const Unit& u, int, int wr, int wc, int fr, int fq) const {
        const int row0 = u.pm * BM + wr * 64 + fr, col0 = u.pn * BM + wc * 64 + 16 * fq;
        f32x4 gm[2][2];
#pragma unroll
        for (int bj = 0; bj < 2; ++bj)
#pragma unroll
            for (int n = 0; n < 2; ++n) gm[bj][n] = *(const f32x4*)(GM + col0 + 8 * bj + 4 * n);
#pragma unroll
        for (int ai = 0; ai < 2; ++ai)
#pragma unroll
            for (int m = 0; m < 4; ++m) { const int row = row0 + ai * HALF + m * 16; const size_t off = (size_t)row * DM + col0; const float rms = RMS[row];
                int q8[4];
#pragma unroll
                for (int bj = 0; bj < 2; ++bj) { const size_t o2 = off + 8 * bj; const u32x4 xw = *(const u32x4*)(XNp + o2);
                    float v[8];
#pragma unroll
                    for (int q = 0; q < 4; ++q) { v[2 * q] = __builtin_bit_cast(float, xw[q] << 16) * rms + acc[ai][bj][m][q >> 1][(q & 1) * 2]; v[2 * q + 1] = __builtin_bit_cast(float, xw[q] & 0xffff0000u) * rms + acc[ai][bj][m][q >> 1][(q & 1) * 2 + 1]; }
                    u32x4 w; w.x = cvt_pk_bf16(v[0], v[1]); w.y = cvt_pk_bf16(v[2], v[3]); w.z = cvt_pk_bf16(v[4], v[5]); w.w = cvt_pk_bf16(v[6], v[7]); *(u32x4*)(X1b + o2) = w;
                    const f32x4 g0 = gm[bj][0], g1 = gm[bj][1];
                    int q0 = 0, q1 = 0; q0 = __builtin_amdgcn_cvt_pk_fp8_f32(v[0] * g0[0], v[1] * g0[1], q0, false); q0 = __builtin_amdgcn_cvt_pk_fp8_f32(v[2] * g0[2], v[3] * g0[3], q0, true);
                    q1 = __builtin_amdgcn_cvt_pk_fp8_f32(v[4] * g1[0], v[5] * g1[1], q1, false); q1 = __builtin_amdgcn_cvt_pk_fp8_f32(v[6] * g1[2], v[7] * g1[3], q1, true);
                    q8[2 * bj] = q0; q8[2 * bj + 1] = q1; }
                u32x4 w8; w8.x = (unsigned)q8[0]; w8.y = (unsigned)q8[1]; w8.z = (unsigned)q8[2]; w8.w = (unsigned)q8[3]; *(u32x4*)(X1q + off) = w8; }
    }
};
struct EpiGU {
    static constexpr bool PERM = true, PERM16 = false; static constexpr int NSTORE = 0;
    unsigned char* ACT; const PG8_LAS unsigned char* utab;
    __device__ __forceinline__ void operator()(const f32x4 (&acc)[2][2][4][2], const Unit& u, int ui, int wr, int wc, int fr, int fq) const {
        const PG8_LAS unsigned char* tb = utab + (ui & 1) * UT_BYTES;
        const PG8_LAS float* rsl = (const PG8_LAS float*)(tb + UT_ROWA); const PG8_LAS float* bl = (const PG8_LAS float*)(tb + UT_BIAS);
        const int rl0 = wr * 64 + fr, cl = wc * 32 + 8 * fq, colt = u.pn * HALF + cl;
        f32x4 bgv[2], buv[2];
#pragma unroll
        for (int n = 0; n < 2; ++n) { bgv[n] = *(const PG8_LAS f32x4*)(bl + cl + 4 * n); buv[n] = *(const PG8_LAS f32x4*)(bl + HALF + cl + 4 * n); }
#pragma unroll
        for (int ai = 0; ai < 2; ++ai)
#pragma unroll
            for (int m = 0; m < 4; ++m) { const int rl = rl0 + ai * HALF + m * 16; const float rs = rsl[rl] * (1.0f / 512.0f);
                float a[8];
#pragma unroll
                for (int n = 0; n < 2; ++n)
#pragma unroll
                    for (int j = 0; j < 4; j += 2) {
                        typedef float f2 __attribute__((ext_vector_type(2)));
                        const f2 rs2 = {rs, rs};
                        f2 g = (f2){acc[ai][0][m][n][j], acc[ai][0][m][n][j + 1]} * rs2 + (f2){bgv[n][j], bgv[n][j + 1]};
                        f2 l = (f2){acc[ai][1][m][n][j], acc[ai][1][m][n][j + 1]} * rs2 + (f2){buv[n][j], buv[n][j + 1]};
                        g.x = fminf(g.x, 7.0f); g.y = fminf(g.y, 7.0f); l.x = fminf(fmaxf(l.x, -7.0f), 7.0f); l.y = fminf(fmaxf(l.y, -7.0f), 7.0f);
                        const f2 t = g * (f2){-1.702f * LOG2E, -1.702f * LOG2E};
                        f2 e; e.x = __builtin_amdgcn_exp2f(t.x); e.y = __builtin_amdgcn_exp2f(t.y);
                        const f2 d = e + (f2){1.0f, 1.0f};
                        f2 sg; sg.x = __builtin_amdgcn_rcpf(d.x); sg.y = __builtin_amdgcn_rcpf(d.y);
                        const f2 r = (g * sg) * (l + (f2){1.0f, 1.0f});
                        a[n * 4 + j] = r.x; a[n * 4 + j + 1] = r.y; }
                int q0 = 0, q1 = 0; q0 = __builtin_amdgcn_cvt_pk_fp8_f32(a[0], a[1], q0, false); q0 = __builtin_amdgcn_cvt_pk_fp8_f32(a[2], a[3], q0, true);
                q1 = __builtin_amdgcn_cvt_pk_fp8_f32(a[4], a[5], q1, false); q1 = __builtin_amdgcn_cvt_pk_fp8_f32(a[6], a[7], q1, true);
                u32x2 w; w.x = (unsigned)q0; w.y = (unsigned)q1;
                *(u32x2*)(ACT + (size_t)(u.pm * BM + rl) * DEXP + colt) = w; }
    }
};
struct EpiDown {
    static constexpr bool PERM = true, PERM16 = true; static constexpr int NSTORE = 0;
    unsigned char* Y; const PG8_LAS unsigned char* utab;
    __device__ __forceinline__ void operator()(const f32x4 (&acc)[2][2][4][2], const Unit& u, int ui, int wr, int wc, int fr, int fq) const {
        const PG8_LAS unsigned char* tb = utab + (ui & 1) * UT_BYTES;
        const PG8_LAS float* gl = (const PG8_LAS float*)(tb + UT_ROWA); const PG8_LAS int* dl = (const PG8_LAS int*)(tb + UT_ROWB); const PG8_LAS float* bl = (const PG8_LAS float*)(tb + UT_BIAS);
        const int rl0 = wr * 64 + fr, cl = wc * 64 + 16 * fq, colt = u.pn * BM + cl;
        f32x4 bv[2][2];
#pragma unroll
        for (int bj = 0; bj < 2; ++bj)
#pragma unroll
            for (int n = 0; n < 2; ++n) bv[bj][n] = *(const PG8_LAS f32x4*)(bl + cl + 8 * bj + 4 * n);
#pragma unroll
        for (int ai = 0; ai < 2; ++ai)
#pragma unroll
            for (int m = 0; m < 4; ++m) { const int rl = rl0 + ai * HALF + m * 16;
                if (rl < u.nv) { const float gt = gl[rl] * 8.0f; const int dst = dl[rl];
                    __attribute__((address_space(1))) unsigned char* rowp = (__attribute__((address_space(1))) unsigned char*)Y + (size_t)dst * DM + colt;
                    int q8[4];
#pragma unroll
                    for (int bj = 0; bj < 2; ++bj) { const f32x4 v0 = (acc[ai][bj][m][0] * (1.0f / 512.0f) + bv[bj][0]) * gt, v1 = (acc[ai][bj][m][1] * (1.0f / 512.0f) + bv[bj][1]) * gt;
                        int q0 = 0, q1 = 0; q0 = __builtin_amdgcn_cvt_pk_fp8_f32(v0[0], v0[1], q0, false); q0 = __builtin_amdgcn_cvt_pk_fp8_f32(v0[2], v0[3], q0, true);
                        q1 = __builtin_amdgcn_cvt_pk_fp8_f32(v1[0], v1[1], q1, false); q1 = __builtin_amdgcn_cvt_pk_fp8_f32(v1[2], v1[3], q1, true);
                        q8[2 * bj] = q0; q8[2 * bj + 1] = q1; }
                    u32x4 w; w.x = (unsigned)q8[0]; w.y = (unsigned)q8[1]; w.z = (unsigned)q8[2]; w.w = (unsigned)q8[3];
                    *(__attribute__((address_space(1))) u32x4*)rowp = w; } }
    }
};

typedef int v8i __attribute__((ext_vector_type(8)));
typedef int v4i __attribute__((ext_vector_type(4)));
template <class Epi, class Sched, bool FP8 = false, int KR = 1, int EREP = 1>
__device__ __forceinline__ void gemm_phase(PG8_LAS unsigned char* lds, const void* Abase, const int K, const Sched& S, const Epi& E, const int wid_in) {
    unsigned z_ = 0u; asm volatile("" : "+s"(z_));
    int tid = wid_in * 64 + (int)__builtin_amdgcn_mbcnt_hi(~0u, __builtin_amdgcn_mbcnt_lo(~0u, z_)); asm volatile("" : "+v"(tid));
    const int wid = wid_in, lane = tid & 63, wr = wid >> 2, wc = wid & 3, fr = lane & 15, fq = lane >> 4;
    const int nt = K / BK;
    unsigned voffA[2], voffB[2];
#pragma unroll
    for (int i = 0; i < 2; ++i) { int R, C; stage_rc(tid * 16 + i * 8192, R, C); const int Rp = Epi::PERM ? ((R & ~31) + perm32(R & 31)) : R;
        const int Rb = Epi::PERM16 ? (2 * (Rp & ~7) + (Rp & 7)) : Rp;
        voffA[i] = (unsigned)(R * K + C) * 2u; voffB[i] = (unsigned)(Rb * (K + Sched::BPAD) + C) * 2u; }
    const size_t kstep = (size_t)(BK * 2);
    const size_t hstep = (size_t)HALF * K * 2;
    const size_t bhstep = Epi::PERM16 ? (size_t)8 * (K + Sched::BPAD) * 2 : (size_t)HALF * (K + Sched::BPAD) * 2;
    const unsigned ldsw = (unsigned)wid * 1024u;
    const int aoff0 = lds_chunk(wr * 64 + fr, fq), boff0 = lds_chunk(wc * 32 + fr, fq) + 4 * HTB;
#define PG8_KH1(off0, var) unsigned var = (unsigned)(off0) ^ 64u; asm volatile("" : "+v"(var))
#define PG8_SA(b, h) (((b) * 2 + (h)) * HTB)
#define PG8_SB(b, h) ((4 + (b) * 2 + (h)) * HTB)
#define PG8_SBR(b, h) (((b) * 2 + (h)) * HTB)
#define PG8_STAGE(bufoff, gbase, voff) do { _Pragma("unroll") for (int _i = 0; _i < 2; ++_i) { unsigned _o = (voff)[_i]; asm volatile("" : "+v"(_o));     \
        __builtin_amdgcn_global_load_lds((const unsigned*)((const char*)(gbase) + _o), (PG8_LAS unsigned*)(lds + (bufoff) + ldsw + _i * 8192), 16, 0, 0); } } while (0)
#define PG8_LD8(a0, a1) __builtin_shufflevector(*(const PG8_LAS v4i*)(a0), *(const PG8_LAS v4i*)(a1), 0, 1, 2, 3, 4, 5, 6, 7)
#define PG8_LDA(dst, b, h) do { PG8_KH1(aoff0, aoff1_); if constexpr (FP8) { _Pragma("unroll") for (int m = 0; m < 4; ++m) dst##8[m] = PG8_LD8(lds + PG8_SA(b, h) + aoff0 + m * 2048, lds + PG8_SA(b, h) + aoff1_ + m * 2048); } \
        else { _Pragma("unroll") for (int m = 0; m < 4; ++m) { dst[m][0] = *(const PG8_LAS bf16x8*)(lds + PG8_SA(b, h) + aoff0 + m * 2048); dst[m][1] = *(const PG8_LAS bf16x8*)(lds + PG8_SA(b, h) + aoff1_ + m * 2048); } } } while (0)
#define PG8_LDB(dst, b, h) do { PG8_KH1(boff0, boff1_); if constexpr (FP8) { _Pragma("unroll") for (int n = 0; n < 2; ++n) dst##8[n] = PG8_LD8(lds + PG8_SBR(b, h) + boff0 + n * 2048, lds + PG8_SBR(b, h) + boff1_ + n * 2048); } \
        else { _Pragma("unroll") for (int n = 0; n < 2; ++n) { dst[n][0] = *(const PG8_LAS bf16x8*)(lds + PG8_SBR(b, h) + boff0 + n * 2048); dst[n][1] = *(const PG8_LAS bf16x8*)(lds + PG8_SBR(b, h) + boff1_ + n * 2048); } } } while (0)
#define PG8_MMA(ai, bj, At, Bt) do { __builtin_amdgcn_s_setprio(1); \
        if constexpr (FP8) { _Pragma("unroll") for (int m = 0; m < 4; ++m) _Pragma("unroll") for (int n = 0; n < 2; ++n) \
            acc[ai][bj][m][n] = __builtin_amdgcn_mfma_scale_f32_16x16x128_f8f6f4(Bt##8[n], At##8[m], acc[ai][bj][m][n], 0, 0, 0, 0x7f7f7f7f, 0, 0x7f7f7f7f); } \
        else { _Pragma("unroll") for (int m = 0; m < 4; ++m) _Pragma("unroll") for (int n = 0; n < 2; ++n) _Pragma("unroll") for (int k = 0; k < 2; ++k) \
            acc[ai][bj][m][n] = __builtin_amdgcn_mfma_f32_16x16x32_bf16(Bt[n][k], At[m][k], acc[ai][bj][m][n], 0, 0, 0); } \
        __builtin_amdgcn_s_setprio(0); } while (0)
#define PG8_WAIT_V(n) asm volatile("s_waitcnt vmcnt(" #n ")" ::: "memory")
#define PG8_WAIT_L(n) asm volatile("s_waitcnt lgkmcnt(" #n ")" ::: "memory")
#define PG8_WAIT_VF(t_) asm volatile("s_cmp_lg_u32 %0, 0\n\ts_cbranch_scc1 1f\n\ts_waitcnt vmcnt(%1)\n\ts_branch 2f\n1:\n\ts_waitcnt vmcnt(8)\n2:" :: "s"(t_), "n"(8 + Epi::NSTORE) : "memory", "scc")
#define PG8_BAR __builtin_amdgcn_s_barrier()
#define PG8_SCHED __builtin_amdgcn_sched_barrier(0)
    Unit cur, nxt; int ui = 0;
    if (!S.next(0, cur)) return;
    f32x4 acc[2][2][4][2];
#pragma unroll
    for (int a = 0; a < 2; ++a)
#pragma unroll
        for (int b = 0; b < 2; ++b)
#pragma unroll
            for (int m = 0; m < 4; ++m)
#pragma unroll
                for (int n = 0; n < 2; ++n) acc[a][b][m][n] = (f32x4){0.f, 0.f, 0.f, 0.f};
    bf16x8 At[4][2], B0[2][2], B1[2][2];
    v8i At8[4], B08[2], B18[2];
    unsigned ca[2][2];
    S.aoffs(cur, tid, ca);
    const char* const Ab = (const char*)Abase;
    const char* cA = Ab + S.abase(cur);
    const char* cB = S.bbase(cur);
#define PG8_STAGE_A(bufoff, kb, h, nx) do { if constexpr (Sched::GATHER) { PG8_STAGE(bufoff, Ab + (kb), ca[h]); } \
        else PG8_STAGE(bufoff, ((nx) ? nA : cA) + (kb) + (h) * hstep, voffA); } while (0)
    const char* nA = cA;
    PG8_STAGE(PG8_SB(0, 0), cB, voffB); PG8_STAGE(PG8_SB(0, 1), cB + bhstep, voffB); PG8_STAGE_A(PG8_SA(0, 0), 0, 0, false); PG8_STAGE_A(PG8_SA(0, 1), 0, 1, false);
    if (wr == 1) PG8_BAR;
    PG8_WAIT_V(2); PG8_BAR;
    PG8_STAGE(PG8_SB(1, 0), cB + kstep, voffB); PG8_STAGE_A(PG8_SA(1, 0), kstep, 0, false); PG8_STAGE(PG8_SB(1, 1), cB + bhstep + kstep, voffB);
    PG8_STAGE_A(PG8_SA(1, 1), kstep, 1, false); PG8_WAIT_V(0);
    PG8_BAR;
    for (;;) {
        const bool has_next = S.next(ui + 1, nxt);
        S.unit_begin(cur, nxt, has_next, ui, wid, lane);
        nA = has_next ? Ab + S.abase(nxt) : cA;
        const char* nB = has_next ? S.bbase(nxt) : cB;
#pragma unroll 1
        for (int t = 0; t < nt * KR; t += 2) {
            const bool last = (t == nt * KR - 2);
            const int tw2 = (KR > 1) ? ((t + 2) & (nt - 1)) : (t + 2);
            const size_t k1 = (size_t)((KR > 1) ? ((t + 1) & (nt - 1)) : (t + 1)) * kstep; const size_t k2 = last ? (size_t)0 : (size_t)tw2 * kstep, k3 = k2 + kstep;
            const char* b2 = last ? nB : cB + (size_t)tw2 * kstep; const char* b3 = b2 + kstep;
            PG8_LDB(B0, 0, 0); PG8_LDB(B1, 0, 1); PG8_SCHED; PG8_LDA(At, 0, 0); if (t != 0) PG8_STAGE_A(PG8_SA(1, 1), k1, 1, false);
            PG8_WAIT_VF(t); PG8_WAIT_L(0); PG8_BAR; PG8_MMA(0, 0, At, B0); PG8_MMA(0, 1, At, B1);
            if (Sched::GATHER && last && has_next) { asm volatile("" ::: "memory"); S.aoffs_lds(nxt, wid, ui, ca); }
            PG8_BAR; PG8_SCHED;
            PG8_LDA(At, 0, 1); PG8_STAGE(PG8_SB(0, 0), b2, voffB); PG8_STAGE(PG8_SB(0, 1), b2 + bhstep, voffB); PG8_STAGE_A(PG8_SA(0, 0), k2, 0, last);
            PG8_WAIT_VF(t); PG8_WAIT_L(0); PG8_BAR; PG8_MMA(1, 0, At, B0); PG8_MMA(1, 1, At, B1); PG8_BAR; PG8_SCHED;
            PG8_LDB(B0, 1, 0); PG8_LDB(B1, 1, 1); PG8_SCHED; PG8_LDA(At, 1, 0); PG8_STAGE_A(PG8_SA(0, 1), k2, 1, last);
            PG8_WAIT_VF(t); PG8_WAIT_L(0); PG8_BAR; PG8_MMA(0, 0, At, B0); PG8_MMA(0, 1, At, B1); PG8_BAR; PG8_SCHED;
            PG8_LDA(At, 1, 1); PG8_STAGE(PG8_SB(1, 0), b3, voffB); PG8_STAGE(PG8_SB(1, 1), b3 + bhstep, voffB); PG8_STAGE_A(PG8_SA(1, 0), k3, 0, last);
            PG8_WAIT_V(8); PG8_WAIT_L(0); PG8_BAR; PG8_MMA(1, 0, At, B0); PG8_MMA(1, 1, At, B1); PG8_BAR; PG8_SCHED;
        }
        PG8_STAGE_A(PG8_SA(1, 1), kstep, 1, true);
        if (wr == 0) PG8_BAR;
        { const int l2 = lane_now();
          E(acc, cur, ui, wr, wc, l2 & 15, l2 >> 4);
          if constexpr (EREP > 1) { asm volatile("" ::: "memory"); const int l3 = lane_now(); E(acc, cur, ui, wr, wc, l3 & 15, l3 >> 4); } }
        if (!has_next) break;
#pragma unroll
        for (int a = 0; a < 2; ++a)
#pragma unroll
            for (int b = 0; b < 2; ++b)
#pragma unroll
                for (int m = 0; m < 4; ++m)
#pragma unroll
                    for (int n = 0; n < 2; ++n) acc[a][b][m][n] = (f32x4){0.f, 0.f, 0.f, 0.f};
        cur = nxt; cB = nB; cA = nA; ++ui;
        if (wr == 1) PG8_BAR;
    }
    PG8_WAIT_V(0);
    PG8_BAR;
#undef PG8_SA
#undef PG8_SB
#undef PG8_SBR
#undef PG8_STAGE
#undef PG8_STAGE_A
#undef PG8_KH1
#undef PG8_LDA
#undef PG8_LDB
#undef PG8_MMA
#undef PG8_WAIT_V
#undef PG8_WAIT_L
#undef PG8_WAIT_VF
#undef PG8_BAR
#undef PG8_SCHED
}
}

typedef unsigned short bf16;
typedef unsigned v4u __attribute__((ext_vector_type(4)));
typedef unsigned v2u __attribute__((ext_vector_type(2)));
typedef float f32x4 __attribute__((ext_vector_type(4)));
typedef float f32x16 __attribute__((ext_vector_type(16)));
typedef short bf16x8 __attribute__((ext_vector_type(8)));
typedef short s16x4 __attribute__((ext_vector_type(4)));
typedef GAS unsigned gu32;
#define RLX_AGENT __ATOMIC_RELAXED, __HIP_MEMORY_SCOPE_AGENT
#define LDS_WAIT() asm volatile("s_waitcnt lgkmcnt(0)" ::: "memory")
#define VM_WAIT() asm volatile("s_waitcnt vmcnt(0)" ::: "memory")
__device__ __forceinline__ unsigned f2bf(float f) { unsigned u = __builtin_bit_cast(unsigned, f); return (u + 0x7fffu + ((u >> 16) & 1u)) >> 16; }
__device__ __forceinline__ unsigned pk2(float lo, float hi) { return f2bf(lo) | (f2bf(hi) << 16); }
__device__ __forceinline__ float bflo(unsigned u) { return __builtin_bit_cast(float, u << 16); }
__device__ __forceinline__ float bfhi(unsigned u) { return __builtin_bit_cast(float, u & 0xffff0000u); }

#define XB_TMO      128
#define XB_XCNT(j)  (256  + 64 * (j))
#define XB_XSUB(j)  (1280 + 64 * (j))
#define XB_XGEN(j)  (2304 + 64 * (j))
#define XB_TOP      3328
#define XB_TOPGEN   3392
#define XCD_BAR_WORDS 3456
#define XB_SPIN_CAP (1u << 18)
__device__ __forceinline__ unsigned xb_ld(unsigned* p)              { return __hip_atomic_load(p, __ATOMIC_RELAXED, __HIP_MEMORY_SCOPE_AGENT); }
__device__ __forceinline__ unsigned xb_add(unsigned* p, unsigned v) { return __hip_atomic_fetch_add(p, v, __ATOMIC_RELAXED, __HIP_MEMORY_SCOPE_AGENT); }
__device__ __forceinline__ unsigned xb_xcc_id() { return (unsigned)__builtin_amdgcn_s_getreg((3 << 11) | 20) & 0xFu; }
#define XB_SPIN(cond, bar) do { unsigned _sp = 0; while (cond) { __builtin_amdgcn_s_sleep(1); \
    if ((++_sp & 255u) == 0u) { if (xb_ld(&(bar)[XB_TMO])) break; if (_sp > XB_SPIN_CAP) { atomicAdd(&(bar)[XB_TMO], 1u); break; } } } } while (0)
struct XcdBarrier { unsigned* bar; unsigned x; volatile LAS unsigned* st; };
__device__ __forceinline__ XcdBarrier xcd_barrier_post(unsigned* bar, volatile LAS unsigned* st) {
    XcdBarrier b; b.bar = bar; b.x = xb_xcc_id(); b.st = st;
    if (threadIdx.x == 0) (void)xb_add(&bar[XB_XCNT(b.x)], 1u);
    return b;
}
__device__ __forceinline__ void xcd_barrier_complete(unsigned* bar, unsigned x, unsigned& nloc, unsigned& nx) {
    const unsigned G = gridDim.x * gridDim.y * gridDim.z;
    unsigned sum, cnt, mine, sp = 0u;
    for (;;) {
        sum = 0u; cnt = 0u; mine = 0u;
#pragma unroll
        for (unsigned j = 0; j < 16; ++j) { const unsigned c = xb_ld(&bar[XB_XCNT(j)]); sum += c; cnt += (c > 0u) ? 1u : 0u; mine = (j == x) ? c : mine; }
        if (sum == G) break;
        __builtin_amdgcn_s_sleep(1);
        if ((++sp & 255u) == 0u) { if (xb_ld(&bar[XB_TMO])) break; if (sp > XB_SPIN_CAP) { atomicAdd(&bar[XB_TMO], 1u); break; } }
    }
    nloc = mine > 0u ? mine : 1u; nx = cnt > 0u ? cnt : 1u;
}
__device__ __forceinline__ void xcd_barrier(const XcdBarrier& b, const int wid) {
    asm volatile("s_waitcnt vmcnt(0)" ::: "memory");
    __syncthreads();
    unsigned zb_ = 0u; asm volatile("" : "+s"(zb_));
    if (wid == 0 && __builtin_amdgcn_mbcnt_hi(~0u, __builtin_amdgcn_mbcnt_lo(~0u, zb_)) == 0u) {
        unsigned* bar = b.bar;
        __builtin_amdgcn_s_waitcnt(0);
        unsigned nloc = b.st[0], nx = b.st[1];
        if (nloc == 0u) { xcd_barrier_complete(bar, b.x, nloc, nx); b.st[0] = nloc; b.st[1] = nx; }
        const unsigned old = xb_add(&bar[XB_XSUB(b.x)], 1u);
        const unsigned gen = old / nloc;
        if (old + 1u == (gen + 1u) * nloc) {
            __builtin_amdgcn_fence(__ATOMIC_RELEASE, "agent");
            asm volatile("s_waitcnt vmcnt(0)" ::: "memory");
            const unsigned og = xb_add(&bar[XB_TOP], 1u);
            const unsigned tg = og / nx;
            if (og + 1u == (tg + 1u) * nx) xb_add(&bar[XB_TOPGEN], 1u);
            else XB_SPIN(xb_ld(&bar[XB_TOPGEN]) == tg, bar);
            __builtin_amdgcn_fence(__ATOMIC_ACQUIRE, "agent");
            xb_add(&bar[XB_XGEN(b.x)], 1u);
            asm volatile("s_waitcnt vmcnt(0)" ::: "memory");
        } else {
            XB_SPIN(xb_ld(&bar[XB_XGEN(b.x)]) == gen, bar);
            __builtin_amdgcn_fence(__ATOMIC_ACQUIRE, "agent");
            asm volatile("s_waitcnt vmcnt(0)" ::: "memory");
        }
    }
    __syncthreads();
}

constexpr size_t MiB = 1u << 20;
constexpr size_t WS_CTL = 0, CTL_ZERO_BYTES = 1 * MiB;
constexpr int WPITCH = DM + 64;
constexpr size_t WS_WQKV = 972 * MiB;
constexpr size_t WS_WO = 980 * MiB;
constexpr size_t WS_WD = 9 * MiB;
constexpr size_t WS_TOK = 41 * MiB;
constexpr size_t WS_GATE = 49 * MiB;
constexpr size_t WS_RS = 57 * MiB;
constexpr size_t WS_DST = 65 * MiB;
constexpr size_t WS_X1B = 73 * MiB;
constexpr size_t WS_X1Q = 201 * MiB;
constexpr size_t WS_BIG = 265 * MiB;
constexpr size_t WS_XN = WS_BIG, WS_QKV = WS_BIG + 128 * MiB, WS_ACT = WS_BIG;
constexpr size_t WS_Y1 = WS_BIG + 264 * MiB;
constexpr size_t WS_WGU = WS_BIG + 512 * MiB;
constexpr size_t WS_O = WS_WGU + 64 * MiB;
constexpr size_t WS_RMS1 = WS_O + 128 * MiB;
constexpr size_t WS_END = 984 * MiB;
static_assert(WS_QKV + (size_t)NTOK * NQKV * 2 <= WS_WGU && WS_ACT + (size_t)NSLOT * DEXP <= WS_Y1 && WS_Y1 + (size_t)NTOK * 2 * DM * 2 <= WS_END && WS_END <= 1024 * MiB, "d_ws map");
constexpr int CW_CNT = 64;
constexpr int CW_BAR = 4096;

constexpr int RING_BYTES = 131072;
constexpr int MISC_OFF = RING_BYTES + 320;
constexpr int HIST_OFF = RING_BYTES + 512, BASE_OFF = RING_BYTES + 640, CNTL_OFF = RING_BYTES + 768, FIRST_OFF = RING_BYTES + 896, RBTAB_OFF = RING_BYTES + 1152;
constexpr int UTAB_OFF = RING_BYTES + 6144;
constexpr int XPOSE_OFF = 147456;
constexpr int LDS_BYTES = 163840;
static_assert(RBTAB_OFF + MAXRB * 4 <= UTAB_OFF && UTAB_OFF + 2 * 4096 <= XPOSE_OFF && XPOSE_OFF + 8 * 2048 <= LDS_BYTES, "LDS map");

struct Args { const float* in[17]; float* out; unsigned char* ws; };

__device__ __forceinline__ float wave_sum(float v) {
#pragma unroll
    for (int o = 1; o < 64; o <<= 1) v += __shfl_xor(v, o);
    return v;
}
__device__ __forceinline__ int crow(int r, int hi) { return (r & 3) + 8 * (r >> 2) + 4 * hi; }

template <bool SIG = false>
__device__ __forceinline__ void p0_item(const float* W, int N, bf16* WTrow  , int K, const float* gk, float sn, int k0, int n0, int lane) {
    const GAS f32x4* src = (const GAS f32x4*)(W + (size_t)k0 * N + n0) + lane;
    const int n4 = N >> 2;
#pragma unroll 2
    for (int g = 0; g < 8; ++g) {
        f32x4 v[8];
#pragma unroll
        for (int i = 0; i < 8; ++i) v[i] = src[(size_t)(8 * g + i) * n4];
#pragma unroll
        for (int i = 0; i < 8; ++i) { const float sc = gk ? gk[k0 + 8 * g + i] * sn : sn; v[i] = v[i] * sc; }
#pragma unroll
        for (int j = 0; j < 4; ++j) { v4u o; o.x = pk2(v[0][j], v[1][j]); o.y = pk2(v[2][j], v[3][j]); o.z = pk2(v[4][j], v[5][j]); o.w = pk2(v[6][j], v[7][j]);
            if (SIG) { v2u lo; lo.x = o.x; lo.y = o.y; v2u hh; hh.x = o.z; hh.y = o.w;
                *(GAS v2u*)(WTrow + (size_t)j * K + k0 + 4 * g) = lo; *(GAS v2u*)(WTrow + (size_t)j * K + k0 + 32 + 4 * g) = hh; }
            else *(GAS v4u*)(WTrow + (size_t)j * K + k0 + 8 * g) = o; }
    }
}
__device__ __forceinline__ void p0_item8(const float* W, int N, unsigned char* WTrow  , int K, const float* gk, float sn, int k0, int n0, int lane) {
    const GAS f32x4* src = (const GAS f32x4*)(W + (size_t)k0 * N + n0) + lane;
    const int n4 = N >> 2;
#pragma unroll 1
    for (int g = 0; g < 4; ++g) {
        f32x4 v[16];
#pragma unroll
        for (int i = 0; i < 16; ++i) v[i] = src[(size_t)(16 * g + i) * n4];
#pragma unroll
        for (int i = 0; i < 16; ++i) { const float sc = gk ? gk[k0 + 16 * g + i] * sn : sn; v[i] = v[i] * sc; }
#pragma unroll
        for (int j = 0; j < 4; ++j) { v4u o;
#pragma unroll
            for (int q = 0; q < 4; ++q) { int w = 0; w = __builtin_amdgcn_cvt_pk_fp8_f32(v[4 * q][j], v[4 * q + 1][j], w, false); w = __builtin_amdgcn_cvt_pk_fp8_f32(v[4 * q + 2][j], v[4 * q + 3][j], w, true); o[q] = (unsigned)w; }
            *(GAS v4u*)(WTrow + (size_t)j * K + k0 + 16 * g) = o; }
    }
}
__device__ __forceinline__ void p0_tile8(const float* W, int N, unsigned char* WT0  , int K, const float* gk, float sn, int k0, int n0, LAS unsigned char* scr, int lane) {
    lane = pg8::lane_now();
    const int ks = lane >> 4, n4 = lane & 15;
    const GAS f32x4* src = (const GAS f32x4*)(W + (size_t)(k0 + 4 * ks) * N + n0) + n4;
    const int n4s = N >> 2;
#pragma unroll 1
    for (int q0 = 0; q0 < 8; q0 += 4) {
        f32x4 v[4][4];
#pragma unroll
        for (int qq = 0; qq < 4; ++qq)
#pragma unroll
            for (int i = 0; i < 4; ++i) v[qq][i] = src[(size_t)(16 * (q0 + qq) + i) * n4s];
#pragma unroll
        for (int qq = 0; qq < 4; ++qq) { const int q = q0 + qq;
#pragma unroll
            for (int i = 0; i < 4; ++i) { const float sc = gk ? gk[k0 + 16 * q + 4 * ks + i] * sn : sn; v[qq][i] = v[qq][i] * sc; }
#pragma unroll
            for (int j = 0; j < 4; ++j) { int w = 0; w = __builtin_amdgcn_cvt_pk_fp8_f32(v[qq][0][j], v[qq][1][j], w, false); w = __builtin_amdgcn_cvt_pk_fp8_f32(v[qq][2][j], v[qq][3][j], w, true);
                const int n = 4 * n4 + j; *(LAS int*)(scr + n * 128 + ((q ^ ((n >> 2) & 7)) << 4) + 4 * ks) = w; } }
    }
#pragma unroll
    for (int i = 0; i < 8; ++i) { const int n = 8 * i + (lane >> 3), c = lane & 7;
        const v4u o = *(const LAS v4u*)(scr + n * 128 + ((c ^ ((n >> 2) & 7)) << 4));
        *(GAS v4u*)(WT0 + (size_t)n * K + k0 + 16 * c) = o; }
}
__device__ __forceinline__ void p0_load2(const float* x, int m, int lane, f32x4 (&v)[2][4]) {
    const GAS f32x4* xr = (const GAS f32x4*)(x + (size_t)m * DM) + lane;
#pragma unroll
    for (int q = 0; q < 2; ++q)
#pragma unroll
        for (int j = 0; j < 4; ++j) v[q][j] = xr[q * 256 + 64 * j];
}
__device__ __forceinline__ void p0_proc2(const f32x4 (&v)[2][4], bf16* XN, float* RMS1, int m, int lane) {
    float s2[2] = {0.f, 0.f};
#pragma unroll
    for (int q = 0; q < 2; ++q) {
#pragma unroll
        for (int j = 0; j < 4; ++j) s2[q] += (v[q][j].x * v[q][j].x + v[q][j].y * v[q][j].y) + (v[q][j].z * v[q][j].z + v[q][j].w * v[q][j].w);
        const float ms = wave_sum(s2[q]) * (1.0f / DM) + RMS_EPS, rstd = 1.0f / sqrtf(ms);
        if (lane == 0) RMS1[m + q] = sqrtf(ms);
        GAS unsigned long long* o8 = (GAS unsigned long long*)(XN + (size_t)(m + q) * DM) + lane;
#pragma unroll
        for (int j = 0; j < 4; ++j) o8[64 * j] = (unsigned long long)pk2(v[q][j].x * rstd, v[q][j].y * rstd) | ((unsigned long long)pk2(v[q][j].z * rstd, v[q][j].w * rstd) << 32);
    }
}
__device__ __forceinline__ void p0_rows(const float* x, bf16* XN, float* RMS1, int m0, int m1, int lane) {
    f32x4 va[2][4], vb[2][4];
    p0_load2(x, m0, lane, va);
#pragma unroll 1
    for (int m = m0; m < m1; m += 4) {
        const bool hb = m + 2 < m1;
        if (hb) p0_load2(x, m + 2, lane, vb);
        p0_proc2(va, XN, RMS1, m, lane);
        if (hb) { if (m + 4 < m1) p0_load2(x, m + 4, lane, va);
            p0_proc2(vb, XN, RMS1, m + 2, lane); }
    }
}

template <int B> __device__ __forceinline__ bf16x8 pack8(const f32x16& p) {
    v4u w; w.x = pg8::cvt_pk_bf16(p[B + 0], p[B + 1]); w.y = pg8::cvt_pk_bf16(p[B + 2], p[B + 3]); w.z = pg8::cvt_pk_bf16(p[B + 4], p[B + 5]); w.w = pg8::cvt_pk_bf16(p[B + 6], p[B + 7]);
    return __builtin_bit_cast(bf16x8, w);
}
typedef short v4i16_t __attribute__((ext_vector_type(4)));
__device__ __forceinline__ s16x4 vtr(const LAS unsigned char* p) { return __builtin_bit_cast(s16x4, __builtin_amdgcn_ds_read_tr16_b64_v4i16((LAS v4i16_t*)p)); }

struct KVt { v4u k[4]; v4u v[4]; };
constexpr int KIMG = 32 * 144, VIMG = 4096, KVIMG = KIMG + VIMG;
__device__ __forceinline__ void kv_put(LAS unsigned char* kst, LAS unsigned char* vst, const KVt& t, int lane) {
#pragma unroll
    for (int i = 0; i < 4; ++i) { *(LAS v4u*)(kst + (8 * i + (lane >> 3)) * 144 + (lane & 7) * 16) = t.k[i];
        *(LAS v4u*)(vst + ((lane & 7) >> 2) * 2048 + (8 * i + (lane >> 3)) * 64 + (lane & 3) * 16) = t.v[i]; }
}
__device__ __forceinline__ f32x16 qk_mma(const LAS unsigned char* kst, const bf16x8 (&qf)[4], int lane) {
    const LAS unsigned char* kp = kst + (lane & 31) * 144 + (lane >> 5) * 16;
    bf16x8 kf[4];
#pragma unroll
    for (int d0 = 0; d0 < 4; ++d0) kf[d0] = *(const LAS bf16x8*)(kp + d0 * 32);
    f32x16 p = {};
#pragma unroll
    for (int d0 = 0; d0 < 4; ++d0) p = __builtin_amdgcn_mfma_f32_32x32x16_bf16(kf[d0], qf[d0], p, 0, 0, 0);
    return p;
}
__device__ __forceinline__ void v_frags(bf16x8 (&vf)[2][2], const LAS unsigned char* vst, int lane) {
    const int hi = lane >> 5, blk = (lane >> 4) & 1, qq = (lane & 15) >> 2, p = lane & 3;
    const LAS unsigned char* vb = vst + (4 * hi + qq) * 64 + blk * 32 + p * 8;
#pragma unroll
    for (int c = 0; c < 2; ++c)
#pragma unroll
        for (int ks = 0; ks < 2; ++ks) {
            const s16x4 lo = vtr(vb + c * 2048 + (16 * ks) * 64), hh = vtr(vb + c * 2048 + (16 * ks + 8) * 64);
            vf[c][ks] = (bf16x8){lo[0], lo[1], lo[2], lo[3], hh[0], hh[1], hh[2], hh[3]};
        }
}
__device__ __forceinline__ void pv_mma(f32x16 (&o)[2], const bf16x8 (&vf)[2][2], const bf16x8 (&pa)[2]) {
#pragma unroll
    for (int c = 0; c < 2; ++c)
#pragma unroll
        for (int ks = 0; ks < 2; ++ks) o[c] = __builtin_amdgcn_mfma_f32_32x32x16_bf16(vf[c][ks], pa[ks], o[c], 0, 0, 0);
}
__device__ __forceinline__ void pv_tile(f32x16 (&o)[2], const LAS unsigned char* vst, const bf16x8 (&pa)[2], int lane) {
    bf16x8 vf[2][2]; v_frags(vf, vst, lane); pv_mma(o, vf, pa);
}
__device__ __forceinline__ void xp32_store(LAS unsigned char* vst, const v4u (&w)[4], bf16* o0, size_t rstr, int lane) {
    const int r32 = lane & 31, hi = lane >> 5, rt = lane >> 3, ct = lane & 7;
#pragma unroll
    for (int i = 0; i < 4; ++i) *(LAS v4u*)(vst + r32 * 128 + (((4 * hi + i) ^ (r32 & 7)) << 4)) = w[i];
    __builtin_amdgcn_wave_barrier();
    v4u d[4];
#pragma unroll
    for (int j = 0; j < 4; ++j) d[j] = *(const LAS v4u*)(vst + (8 * j + rt) * 128 + ((ct ^ rt) << 4));
    __builtin_amdgcn_wave_barrier();
#pragma unroll
    for (int j = 0; j < 4; ++j) *(GAS v4u*)(o0 + (size_t)(8 * j + rt) * rstr + 8 * ct) = d[j];
}
__device__ __forceinline__ void xp32_load(v4u (&t)[4], const bf16* p0, size_t rstr, int lane) {
    const int rt = lane >> 3, ct = lane & 7;
#pragma unroll
    for (int j = 0; j < 4; ++j) t[j] = *(const GAS v4u*)(p0 + (size_t)(8 * j + rt) * rstr + 8 * ct);
}
__device__ __forceinline__ void xp32_unpack(LAS unsigned char* vst, const v4u (&t)[4], v4u (&w)[4], int lane) {
    const int r32 = lane & 31, hi = lane >> 5, rt = lane >> 3, ct = lane & 7;
#pragma unroll
    for (int j = 0; j < 4; ++j) *(LAS v4u*)(vst + (8 * j + rt) * 128 + ((ct ^ rt) << 4)) = t[j];
    __builtin_amdgcn_wave_barrier();
#pragma unroll
    for (int i = 0; i < 4; ++i) w[i] = *(const LAS v4u*)(vst + r32 * 128 + (((4 * hi + i) ^ (r32 & 7)) << 4));
    __builtin_amdgcn_wave_barrier();
}
__device__ __forceinline__ void attn_store(f32x16 (&o)[2], float inv, LAS float* xs  , LAS unsigned char* vst, bf16* o0  , size_t rstr, int wid, int lane) {
    const int r32 = lane & 31, hi = lane >> 5;
    float ss = 0.f;
#pragma unroll
    for (int c = 0; c < 2; ++c)
#pragma unroll
        for (int r = 0; r < 16; ++r) { o[c][r] *= inv; ss += o[c][r] * o[c][r]; }
    ss += __shfl_xor(ss, 32);
    if (hi == 0) xs[wid * 32 + r32] = ss;
    LDS_WAIT(); __builtin_amdgcn_s_barrier(); asm volatile("" ::: "memory");
    float tot = 0.f;
#pragma unroll
    for (int w = 0; w < 8; ++w) tot += xs[w * 32 + r32];
    const float rstd = 1.0f / sqrtf(tot * (1.0f / 512.0f) + RMS_EPS);
    v4u w4[4];
#pragma unroll
    for (int c = 0; c < 2; ++c)
#pragma unroll
        for (int gp = 0; gp < 2; ++gp)
#pragma unroll
            for (int t = 0; t < 4; ++t) w4[2 * c + gp][t] = pg8::cvt_pk_bf16(o[c][8 * gp + 2 * t] * rstd, o[c][8 * gp + 2 * t + 1] * rstd);
    xp32_store(vst, w4, o0, rstr, lane);
}

__global__ void __launch_bounds__(512, 2) hybrid_fwd(Args args) {
    extern __shared__ __attribute__((aligned(16))) unsigned char lds_raw[];
    LAS unsigned char* lds = (LAS unsigned char*)lds_raw;
    volatile LAS unsigned* MISC = (volatile LAS unsigned*)(lds + MISC_OFF);
    const int G = gridDim.x, bx = blockIdx.x;
    const int wid_s = __builtin_amdgcn_readfirstlane((int)threadIdx.x >> 6);
    const int vcu = (G % 8 == 0) ? (bx % 8) * (G / 8) + bx / 8 : bx;
#define ENV() const __attribute__((address_space(4))) Args* ap = (const __attribute__((address_space(4))) Args*)__builtin_amdgcn_kernarg_segment_ptr(); asm volatile("" : "+s"(ap)); \
    unsigned char* const ws = ap->ws; float* const out = ap->out; (void)out; \
    const int wid = wid_s; unsigned z_ = 0u; asm volatile("" : "+s"(z_)); int tid = wid_s * 64 + (int)__builtin_amdgcn_mbcnt_hi(~0u, __builtin_amdgcn_mbcnt_lo(~0u, z_)); asm volatile("" : "+v"(tid)); const int lane = tid & 63; (void)lane; (void)wid; \
    const int gw = vcu * 8 + wid, NGW = G * 8; (void)gw; (void)NGW
#define IN(i) (ap->in[i])
#define GRID_BAR() do { ENV(); XcdBarrier bar_; bar_.bar = (unsigned*)(ws + WS_CTL) + CW_BAR; bar_.x = xb_xcc_id(); bar_.st = (volatile LAS unsigned*)(lds + MISC_OFF) + 8; xcd_barrier(bar_, wid_s); } while (0)
    {
        ENV();
        for (int u = tid; u < (LDS_BYTES - RING_BYTES) / 4; u += 512) ((LAS unsigned*)(lds + RING_BYTES))[u] = 0u;
        __syncthreads();
        (void)xcd_barrier_post((unsigned*)(ws + WS_CTL) + CW_BAR, MISC + 8);
    }

#pragma unroll 1
    for (int rep = 0; rep < REP_P0; ++rep) {
        ENV();
        const float* x = IN(0); const float* g_attn = IN(1); const float* w_qkv = IN(2); const float* g_out_dil = IN(4); const float* g_out_sb = IN(5); const float* w_o = IN(6); const float* g_moe = IN(7);
        const float* w_gate = IN(10); const float* w_up = IN(12); const float* w_down = IN(14);
        bf16* Wqkv_t = (bf16*)(ws + WS_WQKV); bf16* Wo_t = (bf16*)(ws + WS_WO); unsigned char* Wd8 = ws + WS_WD; unsigned char* Wgu8 = ws + WS_WGU; bf16* XN = (bf16*)(ws + WS_XN);
        constexpr int I_QKV = 16 * 12, I_O = 16 * 4, NSMALL = I_QKV + I_O;
        for (int it = gw; it < NSMALL; it += NGW) {
            int r = it;
            if (r < I_QKV) { const int kb = r / 12, nb = r % 12, n0 = 256 * nb; const float sn = (n0 < 512 || (n0 >= 1536 && n0 < 2048)) ? QSCALE : 1.0f;
                p0_item(w_qkv, NQKV, Wqkv_t + (size_t)(n0 + 4 * lane) * WPITCH, WPITCH, g_attn, sn, 64 * kb, n0, lane); continue; }
            r -= I_QKV;
            { const int kb = r / 4, nb = r % 4, n0 = 256 * nb, k0 = 64 * kb;
                p0_item<true>(w_o, DM, Wo_t + (size_t)(n0 + 4 * lane) * WPITCH, WPITCH, (k0 < 512) ? g_out_dil : (g_out_sb - 512), 1.0f, k0, n0, lane); }
        }
        constexpr int NITEMS = NSMALL + 3 * 2048;
        if (NGW == 2048) { const int heavy = NITEMS - 3 * 2048;
            const int nrow = (gw < heavy) ? 18 : 34, m0 = (gw < heavy) ? gw * 18 : heavy * 18 + (gw - heavy) * 34;
            p0_rows(x, XN, (float*)(ws + WS_RMS1), m0, m0 + nrow, lane);
        } else { for (int m = 2 * gw; m < NTOK; m += 2 * NGW) p0_rows(x, XN, (float*)(ws + WS_RMS1), m, m + 2, lane); }
    }
    GRID_BAR();

#pragma unroll 1
    for (int rep = 0; rep < REP_P1; ++rep) {
        ENV();
        bf16* Wqkv_t = (bf16*)(ws + WS_WQKV); bf16* XN = (bf16*)(ws + WS_XN); bf16* QKV = (bf16*)(ws + WS_QKV);
        pg8::DenseOrder S; S.init(NTOK, NQKV, DM, G, bx, Wqkv_t); if (rep > 0) S.maxi = REP_P1_UNITS;
        pg8::EpiQKV E{QKV, NQKV, lds + XPOSE_OFF};
        pg8::gemm_phase<pg8::EpiQKV, pg8::DenseOrder, false, KREP_P1, EREP_P1>(lds, XN, DM, S, E, wid_s);
    }
    GRID_BAR();

    {
        ENV();
        const float* rel_bias = IN(3); bf16* QKV = (bf16*)(ws + WS_QKV); bf16* OB = (bf16*)(ws + WS_O);
        constexpr int SZ0 = 384, PL0 = 128, SZ1 = 192, PL1 = 32, SZ2 = 192, PL2 = 32;
        LAS unsigned char* vst = lds + wid * KVIMG;
        LAS unsigned char* kst = vst + VIMG;
        LAS float* xsb = (LAS float*)(lds + 8 * KVIMG);
        LAS float* tb0 = xsb + 512; LAS float* tb1 = tb0 + 8 * SZ0; LAS float* tb2 = tb1 + 8 * SZ1;
        const float* g_moe = IN(7); const float* w_gate = IN(10); const float* w_up = IN(12); const float* w_down = IN(14); unsigned char* Wd8 = ws + WS_WD; unsigned char* Wgu8 = ws + WS_WGU;
        int cvt_it = gw;
#define CONV_TILE() do { if (cvt_it < NEXP * 3 * 128) { const int e_ = cvt_it / 384, q_ = cvt_it % 384, m_ = q_ / 128, qq_ = q_ % 128, k0_ = 128 * (qq_ >> 4), n0_ = 64 * (qq_ & 15); \
            if (m_ < 2) p0_tile8((m_ == 0 ? w_gate : w_up) + (size_t)e_ * DM * DEXP, DEXP, Wgu8 + ((size_t)e_ * 2048 + (n0_ >> 7) * 256 + m_ * 128 + (n0_ & 127)) * DM, DM, nullptr, 512.0f, k0_, n0_, vst, lane); \
            else p0_tile8(w_down + (size_t)e_ * DEXP * DM, DM, Wd8 + ((size_t)e_ * DM + n0_) * DEXP, DEXP, nullptr, 512.0f, k0_, n0_, vst, lane); \
            cvt_it += NGW; } } while (0)
        static_assert((8 * (SZ0 + SZ1 + SZ2) + 512) * 4 + 8 * KVIMG <= RING_BYTES, "attention LDS");
        bf16* PB = (bf16*)(ws + WS_X1B);
        float* LS = (float*)(ws + WS_X1B + (size_t)NTOK * 512 * 2);
        for (int i = tid; i < 8 * (SZ0 + SZ1 + SZ2); i += 512) {
            int p, rem; if (i < 8 * SZ0) { p = 0; rem = i; } else if (i < 8 * (SZ0 + SZ1)) { p = 1; rem = i - 8 * SZ0; } else { p = 2; rem = i - 8 * (SZ0 + SZ1); }
            const int sz = p == 0 ? SZ0 : (p == 1 ? SZ1 : SZ2), pl = p == 0 ? PL0 : (p == 1 ? PL1 : PL2), hh = rem / sz, j = rem % sz - pl;
            float v = -1e30f;
            if (j >= 0 && j <= 128) { const int dist = j << (2 * p); int bkt = dist;
                if (dist >= 16) bkt = 16 + (dist >= 22) + (dist >= 30) + (dist >= 40) + (dist >= 54) + (dist >= 73) + (dist >= 99) + (dist >= 134) + (dist >= 182) + (dist >= 246)
                                         + (dist >= 332) + (dist >= 450) + (dist >= 609) + (dist >= 825) + (dist >= 1117) + (dist >= 1513);
                v = rel_bias[bkt * 8 + hh] * LOG2E; }
            tb0[i] = v;
        }
        __syncthreads();
        const int r32 = lane & 31, hi = lane >> 5, h = wid;
        int par = 0;
#define A_LOAD(T, tt_, NT_) A_LOADX(T, tt_, NT_, cr, base)
#define A_LOADX(T, tt_, NT_, cr_, base_) do { const int _t = (tt_) < (NT_) ? (tt_) : (NT_) - 1; A_DESC(_t, _p, _kt); const int _sh = 2 * _p, _kb = (cr_) - (128 << _sh) + ((32 * _kt) << _sh); \
            _Pragma("unroll") for (int _i = 0; _i < 4; ++_i) { int _pos = _kb + ((8 * _i + (lane >> 3)) << _sh); _pos = _pos < 0 ? 0 : (_pos > SEQ - 1 ? SEQ - 1 : _pos); \
                const bf16* _row = (base_) + (size_t)_pos * NQKV + h * 64 + (lane & 7) * 8; T.k[_i] = *(const GAS v4u*)(_row + 512); T.v[_i] = *(const GAS v4u*)(_row + 1024); } } while (0)
#define A_STEP(T, tt_, NT_, QS_) do { if ((tt_) < (NT_)) { A_DESC(tt_, p, kt); const int sh = 2 * p, kbase = cr - (128 << sh) + ((32 * kt) << sh); \
            if (kbase + (31 << sh) >= 0) { \
                kv_put(kst, vst, T, lane); \
                const LAS float* bp = (p == 0 ? tb0 + h * SZ0 + PL0 : (p == 1 ? tb1 + h * SZ1 + PL1 : tb2 + h * SZ2 + PL2)) + (128 - 32 * kt + (((QS_) >> sh) * r32) - 4 * hi - 27); \
                f32x16 bv; _Pragma("unroll") for (int r = 0; r < 16; ++r) bv[r] = bp[27 - ((r & 3) + 8 * (r >> 2))]; \
                bf16x8 vf[2][2]; v_frags(vf, vst, lane); \
                f32x16 s = qk_mma(kst, qf, lane); \
                __builtin_amdgcn_sched_barrier(0);     \
                f32x16 pe = s + bv; \
                if (__builtin_expect(kbase < 0, 0)) { asm volatile("; sequence start: keys before position 0 (a real branch, never if-converted)" ::: "memory"); \
                    _Pragma("unroll") for (int r = 0; r < 16; ++r) if (kbase + ((4 * hi + (r & 3) + 8 * (r >> 2)) << sh) < 0) pe[r] = -1e30f; } \
                float mx = fmaxf(fmaxf(pe[0], pe[1]), pe[2]);     \
                _Pragma("unroll") for (int r = 3; r < 15; r += 2) mx = fmaxf(fmaxf(mx, pe[r]), pe[r + 1]); \
                mx = fmaxf(mx, pe[15]); \
                mx = fmaxf(mx, __shfl_xor(mx, 32)); \
                  \
                  \
                if (__any(mx > m_run + 8.0f)) { const float m_new = fmaxf(m_run, mx), f = __builtin_amdgcn_exp2f(m_run - m_new); m_run = m_new; l_run *= f; \
                    _Pragma("unroll") for (int c = 0; c < 2; ++c) _Pragma("unroll") for (int r = 0; r < 16; ++r) o[c][r] *= f; } \
                _Pragma("unroll") for (int r = 0; r < 16; ++r) { pe[r] = __builtin_amdgcn_exp2f(pe[r] - m_run); l_run += pe[r]; } \
                bf16x8 pa[2]; pa[0] = pack8<0>(pe); pa[1] = pack8<8>(pe); \
                pv_mma(o, vf, pa); } } } while (0)
#define A_PRELOAD(NT_, cr_, base_, qpos_) do { A_LOADX(T0, 0, NT_, cr_, base_); A_LOADX(T1, 1, NT_, cr_, base_); \
            _Pragma("unroll") for (int d0 = 0; d0 < 4; ++d0) qf[d0] = *(const GAS bf16x8*)((base_) + (size_t)(qpos_) * NQKV + h * 64 + d0 * 16 + hi * 8); } while (0)
#define A_STREAM(NT_, QS_) do { \
            constexpr int _TS = (((NT_) - 5) / 3) * 3 + 3; \
            _Pragma("unroll 1") for (int tt = 0; tt + 4 < (NT_); tt += 3) { \
                A_LOAD(T2, tt + 2, NT_); A_STEP(T0, tt, NT_, QS_); \
                A_LOAD(T0, tt + 3, NT_); A_STEP(T1, tt + 1, NT_, QS_); \
                A_LOAD(T1, tt + 4, NT_); A_STEP(T2, tt + 2, NT_, QS_); } \
            if (_TS + 2 < (NT_)) A_LOAD(T2, _TS + 2, NT_); A_STEP(T0, _TS, NT_, QS_); \
            if (_TS + 3 < (NT_)) A_LOAD(T0, _TS + 3, NT_); if (_TS + 1 < (NT_)) A_STEP(T1, _TS + 1, NT_, QS_); \
            if (_TS + 4 < (NT_)) A_LOAD(T1, _TS + 4, NT_); if (_TS + 2 < (NT_)) A_STEP(T2, _TS + 2, NT_, QS_); \
            if (_TS + 3 < (NT_)) A_STEP(T0, _TS + 3, NT_, QS_); \
            static_assert(_TS % 3 == 0 && _TS + 4 >= (NT_) && _TS < (NT_), "stream tail"); } while (0)
#define A_DESC(tt, p_, kt_) const int p_ = 2, kt_ = (tt)
#pragma unroll 1
        for (int rep = 0; rep < REP_A; ++rep) { KVt T0, T1, T2; bf16x8 qf[4]; bool pre = false;
        for (int q = 0; vcu + (q >> 2) * G < BATCH * 16 * 4; ++q) {
            const int sup = vcu + (q >> 2) * G, b = sup >> 6, ch = (sup >> 2) & 15, rho = (sup & 3) + 4 * (q & 3), cr = 512 * ch + rho;
            const int qpos = cr + 16 * r32;
            const bf16* base = QKV + (size_t)b * SEQ * NQKV;
            if (!pre) A_PRELOAD(5, cr, base, qpos);
            f32x16 o[2]; o[0] = f32x16{}; o[1] = f32x16{};
            float m_run = -1e20f, l_run = 0.f;
            A_STREAM(5, 16);
            const bool conv = rep == 0 && ((q + bx) & 3) == 3;
            pre = false && (vcu + ((q + 1) >> 2) * G < BATCH * 16 * 4) && !conv;
            if (pre) { const int supn = vcu + ((q + 1) >> 2) * G, bn = supn >> 6, crn = 512 * ((supn >> 2) & 15) + (supn & 3) + 4 * ((q + 1) & 3); A_PRELOAD(5, crn, QKV + (size_t)bn * SEQ * NQKV, crn + 16 * r32); }
            l_run += __shfl_xor(l_run, 32);
            const float inv = 1.0f / l_run;
            { v4u w4[4];
#pragma unroll
              for (int c = 0; c < 2; ++c)
#pragma unroll
                  for (int gp = 0; gp < 2; ++gp)
#pragma unroll
                      for (int t = 0; t < 4; ++t) w4[2 * c + gp][t] = pg8::cvt_pk_bf16(o[c][8 * gp + 2 * t] * inv, o[c][8 * gp + 2 * t + 1] * inv);
              xp32_store(vst, w4, PB + ((size_t)b * SEQ + cr) * 512 + h * 64, (size_t)16 * 512, lane); }
            if (hi == 0) LS[((size_t)b * SEQ + qpos) * 8 + h] = m_run + __builtin_amdgcn_logf(l_run);
            if (conv) CONV_TILE();
        } }
#undef A_DESC
        bf16x8 Tm[2];
#pragma unroll
        for (int ks = 0; ks < 2; ++ks) { v4u w;
#pragma unroll
            for (int jj = 0; jj < 4; ++jj) { const unsigned a = (crow(8 * ks + 2 * jj, hi) >= r32) ? 0x3F80u : 0u, bq = (crow(8 * ks + 2 * jj + 1, hi) >= r32) ? 0x3F80u : 0u; w[jj] = a | (bq << 16); }
            Tm[ks] = __builtin_bit_cast(bf16x8, w); }
#define B_LOAD(T, k_) B_LOADX(T, k_, base)
#define B_LOADX(T, k_, base_) do { const int _k = (k_) < 0 ? 0 : (k_); \
            _Pragma("unroll") for (int _i = 0; _i < 4; ++_i) { const bf16* _row = (base_) + (size_t)(_k + 8 * _i + (lane >> 3)) * NQKV + h * 64 + (lane & 7) * 8; \
                T.k[_i] = *(const GAS v4u*)(_row + 2048); T.v[_i] = *(const GAS v4u*)(_row + 2560); } } while (0)
#define B_STEP(T, k0, DIAG) do { \
            kv_put(kst, vst, T, lane); \
            f32x16 z = qk_mma(kst, qf, lane); \
            f32x16 sp; \
            _Pragma("unroll") for (int r = 0; r < 16; ++r) { z[r] = fminf(z[r], 126.0f); \
                const float v = __builtin_amdgcn_logf(1.0f + __builtin_amdgcn_exp2f(z[r])); \
                sp[r] = (!(DIAG) || ((k0) + crow(r, hi)) < qpos) ? v : 0.f; } \
            bf16x8 sb[2]; sb[0] = pack8<0>(sp); sb[1] = pack8<8>(sp); \
            f32x16 cs; \
            _Pragma("unroll") for (int r = 0; r < 16; ++r) cs[r] = carry; \
            cs = __builtin_amdgcn_mfma_f32_32x32x16_bf16(Tm[0], sb[0], cs, 0, 0, 0); \
            cs = __builtin_amdgcn_mfma_f32_32x32x16_bf16(Tm[1], sb[1], cs, 0, 0, 0); \
            f32x16 pe; \
            _Pragma("unroll") for (int r = 0; r < 16; ++r) { const float v = __builtin_amdgcn_exp2f(z[r] - cs[r]); pe[r] = (!(DIAG) || ((k0) + crow(r, hi)) < qpos) ? v : 0.f; } \
            bf16x8 pa[2]; pa[0] = pack8<0>(pe); pa[1] = pack8<8>(pe); \
            pv_tile(o, vst, pa, lane); \
            carry = __shfl(cs[0], r32); } while (0)
#define B_DONE(k0) ((k0) == 0 || __all(carry > 150.0f))
#pragma unroll 1
        for (int rep = 0; rep < REP_B; ++rep) { KVt T0, T1, T2; bf16x8 qf[4]; bool pre = false;
#define B_PRELOAD(t0_, base_, qpos_) do { B_LOADX(T0, t0_, base_); B_LOADX(T1, (t0_) - 32, base_); \
            _Pragma("unroll") for (int d0 = 0; d0 < 4; ++d0) qf[d0] = *(const GAS bf16x8*)((base_) + (size_t)(qpos_) * NQKV + 1536 + h * 64 + d0 * 16 + hi * 8); } while (0)
        for (int item = vcu; item < BATCH * (SEQ / 32); item += G, par ^= 1) {
            const int b = item >> 8, qt = item & 255, t0 = 32 * qt, qpos = t0 + r32;
            const bf16* base = QKV + (size_t)b * SEQ * NQKV;
            if (!pre) B_PRELOAD(t0, base, qpos);
            f32x16 o[2]; o[0] = f32x16{}; o[1] = f32x16{};
            float carry = 0.f;
            int k0 = t0;
            B_LOAD(T2, k0 - 64); B_STEP(T0, k0, true);
            if (!B_DONE(k0)) { k0 -= 32;
#pragma unroll 1
                for (;;) {
                    B_LOAD(T0, k0 - 64); B_STEP(T1, k0, false); if (B_DONE(k0)) break; k0 -= 32;
                    B_LOAD(T1, k0 - 64); B_STEP(T2, k0, false); if (B_DONE(k0)) break; k0 -= 32;
                    B_LOAD(T2, k0 - 64); B_STEP(T0, k0, false); if (B_DONE(k0)) break; k0 -= 32;
                } }
            const bool conv = rep == 0 && ((((item - vcu) / G) + bx) & 3) == 3;
            pre = (item + G < BATCH * (SEQ / 32)) && !conv;
            if (pre) { const int itn = item + G, bn = itn >> 8, t0n = 32 * (itn & 255); B_PRELOAD(t0n, QKV + (size_t)bn * SEQ * NQKV, t0n + r32); }
            attn_store(o, 1.0f, xsb + par * 256, vst, OB + ((size_t)b * SEQ + (qpos - r32)) * DM + 512 + h * 64, (size_t)DM, wid, lane);
            if (conv) CONV_TILE();
        } }
#undef B_PRELOAD
#undef B_LOADX
#undef B_LOAD
#undef B_STEP
#undef B_DONE
        VM_WAIT();
#define A_DESC(tt, p_, kt_) const int p_ = ((tt) >= 8) ? 1 : 0, kt_ = (tt) - (p_ ? 8 : 0)
#pragma unroll 1
        for (int rep = 0; rep < REP_A; ++rep) { KVt T0, T1, T2; bf16x8 qf[4]; bool pre = false;
        for (int q = 0; vcu + (q >> 2) * G < BATCH * 16 * 4; ++q, par ^= 1) {
            const int sup = vcu + (q >> 2) * G, b = sup >> 6, blk = 4 * ((sup >> 2) & 15) + (q & 3), rho = sup & 3, cr = 128 * blk + rho;
            const int qpos = cr + 4 * r32;
            const bf16* base = QKV + (size_t)b * SEQ * NQKV;
            if (!pre) A_PRELOAD(13, cr, base, qpos);
            f32x16 o[2]; o[0] = f32x16{}; o[1] = f32x16{};
            float m_run = -1e20f, l_run = 0.f;
            v4u pt[4];
            xp32_load(pt, PB + ((size_t)b * SEQ + cr) * 512 + h * 64, (size_t)4 * 512, lane);
            const float lse3 = LS[((size_t)b * SEQ + qpos) * 8 + h];
            A_STREAM(13, 4);
            const bool conv = rep == 0 && ((q + bx) & 3) == 3;
            pre = false && (vcu + ((q + 1) >> 2) * G < BATCH * 16 * 4) && !conv;
            if (pre) { const int supn = vcu + ((q + 1) >> 2) * G, bn = supn >> 6, crn = 128 * (4 * ((supn >> 2) & 15) + ((q + 1) & 3)) + (supn & 3); A_PRELOAD(13, crn, QKV + (size_t)bn * SEQ * NQKV, crn + 4 * r32); }
            l_run += __shfl_xor(l_run, 32);
            { v4u pw4[4]; xp32_unpack(vst, pt, pw4, lane);
              const float m = fmaxf(m_run, lse3), a12 = __builtin_amdgcn_exp2f(m_run - m), a3 = __builtin_amdgcn_exp2f(lse3 - m);
              l_run = l_run * a12 + a3;
#pragma unroll
              for (int c = 0; c < 2; ++c)
#pragma unroll
                  for (int gp = 0; gp < 2; ++gp)
#pragma unroll
                      for (int t = 0; t < 4; ++t) { o[c][8 * gp + 2 * t] = o[c][8 * gp + 2 * t] * a12 + bflo(pw4[2 * c + gp][t]) * a3; o[c][8 * gp + 2 * t + 1] = o[c][8 * gp + 2 * t + 1] * a12 + bfhi(pw4[2 * c + gp][t]) * a3; } }
            attn_store(o, 1.0f / l_run, xsb + par * 256, vst, OB + ((size_t)b * SEQ + cr) * DM + h * 64, (size_t)4 * DM, wid, lane);
            if (conv) CONV_TILE();
        } }
        while (cvt_it < NEXP * 3 * 128) CONV_TILE();
#undef CONV_TILE
#undef A_DESC
#undef A_LOAD
#undef A_LOADX
#undef A_PRELOAD
#undef A_STEP
#undef A_STREAM
    }
    GRID_BAR();

#pragma unroll 1
    for (int rep = 0; rep < REP_P3; ++rep) {
        ENV();
        bf16* Wo_t = (bf16*)(ws + WS_WO); bf16* OB = (bf16*)(ws + WS_O); bf16* X1B = (bf16*)(ws + WS_X1B); unsigned char* X1Q = ws + WS_X1Q;
        pg8::DenseOrder S; S.init(NTOK, DM, DM, G, bx, Wo_t);
        pg8::EpiWo E{(const pg8::bf16_t*)(ws + WS_XN), (const float*)(ws + WS_RMS1), X1B, X1Q, IN(7)};
        pg8::gemm_phase<pg8::EpiWo, pg8::DenseOrder>(lds, OB, DM, S, E, wid_s);
    }
    GRID_BAR();

    {
        ENV();
        const float* g_moe = IN(7); const float* w_router = IN(8); const float* b_router = IN(9); const bf16* X1B = (const bf16*)(ws + WS_X1B);
        int* tok_list = (int*)(ws + WS_TOK); float* gate_list = (float*)(ws + WS_GATE); float* rs_list = (float*)(ws + WS_RS); int* dst_list = (int*)(ws + WS_DST);
        unsigned* cnt_g = (unsigned*)(ws + WS_CTL) + CW_CNT;
        LAS unsigned short* Wt = (LAS unsigned short*)lds;
        LAS unsigned* hist = (LAS unsigned*)(lds + HIST_OFF); LAS unsigned* basel = (LAS unsigned*)(lds + BASE_OFF);
        for (int s = tid; s < DM * NEXP; s += 512) { const int k = s >> 5, e = s & 31; const float w = g_moe[k] * w_router[s];
            const unsigned wh = f2bf(w); const unsigned wl_ = f2bf(w - __builtin_bit_cast(float, wh << 16));
            const int idx = (((k >> 4) * 2 + ((k >> 3) & 1)) * 32 + e) * 16 + (k & 7); Wt[idx] = (unsigned short)wh; Wt[idx + 8] = (unsigned short)wl_; }
        if (tid < 32) hist[tid] = 0u;
        __syncthreads();
        const int r32 = lane & 31, hi = lane >> 5;
        for (int chunk = bx; chunk < NTOK / 256; chunk += G) {
            const int row = chunk * 256 + wid * 32 + r32;
            const GAS v4u* xr = (const GAS v4u*)(X1B + (size_t)row * DM + 8 * hi);
            const LAS bf16x8* wl = (const LAS bf16x8*)Wt + (hi * 32 + r32) * 2;
            f32x16 acc = {}; float ssq = 0.f;
#pragma unroll 4
            for (int i = 0; i < 64; ++i) { const v4u xv = xr[2 * i]; const bf16x8 wh = wl[i * 128], wlo = wl[i * 128 + 1];
                const bf16x8 xb = __builtin_bit_cast(bf16x8, xv);
                acc = __builtin_amdgcn_mfma_f32_32x32x16_bf16(wh, xb, acc, 0, 0, 0); acc = __builtin_amdgcn_mfma_f32_32x32x16_bf16(wlo, xb, acc, 0, 0, 0);
                const float v0 = bflo(xv.x), v1 = bfhi(xv.x), v2 = bflo(xv.y), v3 = bfhi(xv.y), v4 = bflo(xv.z), v5 = bfhi(xv.z), v6 = bflo(xv.w), v7 = bfhi(xv.w);
                ssq += ((v0 * v0 + v1 * v1) + (v2 * v2 + v3 * v3)) + ((v4 * v4 + v5 * v5) + (v6 * v6 + v7 * v7)); }
            ssq += __shfl_xor(ssq, 32);
            const float rstd2 = 1.0f / sqrtf(ssq * (1.0f / DM) + RMS_EPS);
            float lg[16];
#pragma unroll
            for (int r = 0; r < 16; ++r) lg[r] = acc[r] * rstd2 + b_router[crow(r, hi)];
            float tv[4]; int ti[4];
#pragma unroll
            for (int k = 0; k < 4; ++k) {
                float bv = lg[0]; int bi = crow(0, hi);
#pragma unroll
                for (int r = 1; r < 16; ++r) { if (lg[r] > bv) { bv = lg[r]; bi = crow(r, hi); } }
                const float pv = __shfl_xor(bv, 32); const int pi = __shfl_xor(bi, 32);
                const bool mine = (bv > pv) || (bv == pv && bi < pi);
                tv[k] = mine ? bv : pv; ti[k] = mine ? bi : pi;
#pragma unroll
                for (int r = 0; r < 16; ++r) if (mine && crow(r, hi) == bi) lg[r] = -3.0e38f;
            }
            float ge[4]; float gs = 0.f;
#pragma unroll
            for (int k = 0; k < 4; ++k) { ge[k] = __builtin_amdgcn_exp2f((tv[k] - tv[0]) * LOG2E); gs += ge[k]; }
            const float ginv = 1.0f / gs;
            unsigned rank[4] = {0u, 0u, 0u, 0u};
            if (hi == 0) {
#pragma unroll
                for (int k = 0; k < 4; ++k) rank[k] = __hip_atomic_fetch_add(hist + ti[k], 1u, __ATOMIC_RELAXED, __HIP_MEMORY_SCOPE_WORKGROUP);
            }
            __syncthreads();
            if (tid < 32) basel[tid] = __hip_atomic_fetch_add(cnt_g + tid, hist[tid], RLX_AGENT);
            __syncthreads();
            if (hi == 0) {
#pragma unroll
                for (int k = 0; k < 4; ++k) { const size_t li = (size_t)ti[k] * NTOK + basel[ti[k]] + rank[k];
                    tok_list[li] = row; gate_list[li] = ge[k] * ginv; rs_list[li] = rstd2; dst_list[li] = row * 4 + k; }
            }
            __syncthreads();
            if (tid < 32) hist[tid] = 0u;
            __syncthreads();
        }
    }
    GRID_BAR();

    LAS int* cntl = (LAS int*)(lds + CNTL_OFF); LAS int* firstl = (LAS int*)(lds + FIRST_OFF); LAS int* rbtab = (LAS int*)(lds + RBTAB_OFF);
    {
    ENV();
    unsigned* cnt_g = (unsigned*)(ws + WS_CTL) + CW_CNT;
    if (tid < 64) {
        int c = 0; if (tid < 32) c = (int)__hip_atomic_load(cnt_g + tid, RLX_AGENT);
        const int nrb = (c + 255) >> 8; int inc = nrb;
#pragma unroll
        for (int o = 1; o < 32; o <<= 1) { const int t = __shfl_up(inc, o); if ((tid & 31) >= o) inc += t; }
        if (tid < 32) { cntl[tid] = c; firstl[tid] = inc - nrb; if (tid == 31) firstl[32] = inc; }
    }
    __syncthreads();
    const int nRB0 = firstl[32];
    for (int rb = tid; rb < nRB0; rb += 512) { int e = 0;
#pragma unroll 1
        for (int q = 1; q < 32; ++q) e += (firstl[q] <= rb) ? 1 : 0;
        rbtab[rb] = (e << 16) | (rb - firstl[e]); }
    __syncthreads();
    }
    const int nRB = __builtin_amdgcn_readfirstlane(firstl[32]);

#pragma unroll 1
    for (int rep = 0; rep < REP_P5; ++rep) {
        ENV();
        const float* b_gate = IN(11); const float* b_up = IN(13); unsigned char* Wgu8 = ws + WS_WGU; unsigned char* X1Q = ws + WS_X1Q; unsigned char* ACT = ws + WS_ACT;
        int* tok_list = (int*)(ws + WS_TOK); float* rs_list = (float*)(ws + WS_RS);
        pg8::MoeOrder<true> S{G, bx, 8, nRB, DM / 2, (const char*)Wgu8, (size_t)2048 * DM, rbtab, cntl, tok_list, lds + UTAB_OFF, rs_list, nullptr, b_gate, b_up};
        pg8::EpiGU E{ACT, lds + UTAB_OFF};
        pg8::gemm_phase<pg8::EpiGU, pg8::MoeOrder<true>, true>(lds, X1Q, DM / 2, S, E, wid_s);
    }
    GRID_BAR();

#pragma unroll 1
    for (int rep = 0; rep < REP_P6; ++rep) {
        ENV();
        const float* b_down = IN(15); unsigned char* Wd8 = ws + WS_WD; unsigned char* ACT = ws + WS_ACT;
        float* gate_list = (float*)(ws + WS_GATE); int* dst_list = (int*)(ws + WS_DST);
        pg8::MoeOrder<false> S{G, bx, 4, nRB, DEXP / 2, (const char*)Wd8, (size_t)DM * DEXP, rbtab, cntl, nullptr, lds + UTAB_OFF, gate_list, dst_list, b_down, nullptr};
        pg8::EpiDown E{(unsigned char*)out, lds + UTAB_OFF};
        pg8::gemm_phase<pg8::EpiDown, pg8::MoeOrder<false>, true>(lds, ACT, DEXP / 2, S, E, wid_s);
    }
    GRID_BAR();

    {
        ENV();
        const float* g_final = IN(16); bf16* X1B = (bf16*)(ws + WS_X1B); const unsigned char* Y = (const unsigned char*)out;
        f32x4 gf[4];
#pragma unroll
        for (int q = 0; q < 4; ++q) gf[q] = *(const f32x4*)(g_final + 16 * lane + 4 * q);
#define P7_LOAD(XA, YA, M0) do { _Pragma("unroll") for (int t = 0; t < 2; ++t) { \
                _Pragma("unroll") for (int j = 0; j < 2; ++j) XA[t][j] = *(const GAS v4u*)(X1B + (size_t)((M0) + t) * DM + 16 * lane + 8 * j); \
                _Pragma("unroll") for (int k = 0; k < 4; ++k) YA[t][k] = *(const GAS v4u*)(Y + ((size_t)((M0) + t) * 4 + k) * DM + 16 * lane); } } while (0)
        v4u xa[2][2], ya[2][4], xn2[2][2], yn2[2][4];
        if (2 * gw < NTOK) P7_LOAD(xa, ya, 2 * gw);
#pragma unroll 1
        for (int m0 = 2 * gw; m0 < NTOK; m0 += 2 * NGW) {
            const bool more = m0 + 2 * NGW < NTOK;
            if (more) P7_LOAD(xn2, yn2, m0 + 2 * NGW);
#pragma unroll
            for (int t = 0; t < 2; ++t) {
                float v[16]; float s2 = 0.f;
#pragma unroll
                for (int q = 0; q < 4; ++q) {
                    float y0 = 0.f, y1 = 0.f, y2 = 0.f, y3 = 0.f;
#pragma unroll
                    for (int k = 0; k < 4; ++k) { const auto lo = __builtin_amdgcn_cvt_pk_f32_fp8((int)ya[t][k][q], false), hh = __builtin_amdgcn_cvt_pk_f32_fp8((int)ya[t][k][q], true);
                        y0 += lo[0]; y1 += lo[1]; y2 += hh[0]; y3 += hh[1]; }
                    const unsigned w0 = xa[t][q >> 1][(q & 1) * 2], w1 = xa[t][q >> 1][(q & 1) * 2 + 1];
                    v[4 * q] = bflo(w0) + y0 * (1.0f / 8.0f); v[4 * q + 1] = bfhi(w0) + y1 * (1.0f / 8.0f); v[4 * q + 2] = bflo(w1) + y2 * (1.0f / 8.0f); v[4 * q + 3] = bfhi(w1) + y3 * (1.0f / 8.0f);
                    s2 += (v[4 * q] * v[4 * q] + v[4 * q + 1] * v[4 * q + 1]) + (v[4 * q + 2] * v[4 * q + 2] + v[4 * q + 3] * v[4 * q + 3]); }
                const float rstd = 1.0f / sqrtf(wave_sum(s2) * (1.0f / DM) + RMS_EPS);
                GAS f32x4* op = (GAS f32x4*)(out + (size_t)(m0 + t) * DM + 16 * lane);
#pragma unroll
                for (int q = 0; q < 4; ++q) op[q] = (f32x4){v[4 * q] * rstd * gf[q].x, v[4 * q + 1] * rstd * gf[q].y, v[4 * q + 2] * rstd * gf[q].z, v[4 * q + 3] * rstd * gf[q].w};
            }
            if (more) {
#pragma unroll
                for (int t = 0; t < 2; ++t) {
#pragma unroll
                    for (int j = 0; j < 2; ++j) xa[t][j] = xn2[t][j];
#pragma unroll
                    for (int k = 0; k < 4; ++k) ya[t][k] = yn2[t][k]; } }
        }
#undef P7_LOAD
    }
}

extern "C" void kernel_launch(void* const* d_in, const int* in_sizes, int n_in, void* d_out, int out_size, void* d_ws, size_t ws_size, hipStream_t stream) {
    static int grid = 0;
    if (grid == 0) {
        if (n_in != 17 || out_size != NTOK * DM || ws_size < WS_END) { fprintf(stderr, "kernel_launch: unexpected shapes (n_in %d, out %d, ws %zu)\n", n_in, out_size, ws_size); grid = -1; return; }
        int dev = 0, cus = 0;
        if (hipGetDevice(&dev) != hipSuccess || hipDeviceGetAttribute(&cus, hipDeviceAttributeMultiprocessorCount, dev) != hipSuccess) { grid = -1; return; }
        if (hipFuncSetAttribute((const void*)hybrid_fwd, hipFuncAttributeMaxDynamicSharedMemorySize, LDS_BYTES) != hipSuccess) { grid = -1; return; }
        int per_cu = 0;
        if (hipOccupancyMaxActiveBlocksPerMultiprocessor(&per_cu, (const void*)hybrid_fwd, 512, LDS_BYTES) != hipSuccess || per_cu < 1) { fprintf(stderr, "kernel_launch: occupancy query says %d\n", per_cu); }
        (void)hipGetLastError();
        grid = cus;
    }
    if (grid < 0) return;
    if (hipMemsetAsync((char*)d_ws + WS_CTL, 0, CTL_ZERO_BYTES, stream) != hipSuccess) return;
    Args a{};
    for (int i = 0; i < 17; ++i) a.in[i] = (const float*)d_in[i];
    a.out = (float*)d_out; a.ws = (unsigned char*)d_ws;
    hipLaunchKernelGGL(hybrid_fwd, dim3(grid), dim3(512), LDS_BYTES, stream, a);
}
```
